# Optimizing an MI355X kernel written in HIP

```python
import jax, jax.numpy as jnp
from jax import lax
import numpy as np

D_MODEL = 2048
BATCH = 4
SEQ = 4096
DEPTH = 2

GRID_W = 64
CTX_LEN = 256
N_MIXERS = 2
N_HGRN_LAYERS = (DEPTH + 1) // 2
N_MLA_LAYERS = DEPTH // 2

HG_HEADS = 16
HG_DK = 128
HG_DV = D_MODEL // HG_HEADS
HG_KW = HG_HEADS * HG_DK
HG_VW = HG_HEADS * HG_DV
HG_CHUNK = 64

MLA_HEADS = 16
MLA_Q_RANK = 512
MLA_KV_RANK = 512
MLA_NOPE = 128
MLA_ROPE = 64
MLA_V = 128
MLA_SCALE = (MLA_NOPE + MLA_ROPE) ** -0.5
ROPE_BASE = 10000.0
Q_BLOCK = 128

N_EXPERTS = 32
TOP_K = 4
D_EXPERT = 2048
SWIGLU_LIMIT = 7.0
SWIGLU_ALPHA = 1.702
EXPERT_BLOCK = 128

DEEPNORM_ALPHA = (2 * DEPTH) ** 0.25
DEEPNORM_BETA = (8 * DEPTH) ** -0.25
LN_EPS = 1e-5
RMS_EPS = 1e-6
N_MOD = 6

kernel_name = 'hybrid_hgrn2_mla_moe_dit'


def layer_norm(x):
    xf = x.astype(jnp.float32)
    mu = jnp.mean(xf, axis=-1, keepdims=True)
    var = jnp.mean(jnp.square(xf - mu), axis=-1, keepdims=True)
    return (xf - mu) * lax.rsqrt(var + LN_EPS)


def rms_norm(x, w):
    xf = x.astype(jnp.float32)
    return (xf * lax.rsqrt(jnp.mean(xf * xf, axis=-1, keepdims=True) + RMS_EPS) * w).astype(x.dtype)


def modulate(x, shift, scale):
    return (layer_norm(x) * (1.0 + scale) + shift).astype(x.dtype)


def post_norm(x, y, gate, g, b):
    return (layer_norm(DEEPNORM_ALPHA * x + gate * y) * g + b).astype(x.dtype)


def axial_rope_tables(n_tokens):
    rows = n_tokens // GRID_W
    row = jnp.repeat(jnp.arange(rows, dtype=jnp.float32), GRID_W)
    col = jnp.tile(jnp.arange(GRID_W, dtype=jnp.float32), rows)
    n_freq = MLA_ROPE // 4
    freqs = ROPE_BASE ** (-jnp.arange(n_freq, dtype=jnp.float32) / n_freq)
    ang_r = row[:, None] * freqs
    ang_c = col[:, None] * freqs
    return (jnp.cos(ang_r), jnp.sin(ang_r), jnp.cos(ang_c), jnp.sin(ang_c))


def rotate(x, cos, sin):
    n = x.shape[-1] // 2
    x1, x2 = x[..., :n], x[..., n:]
    return jnp.concatenate([x1 * cos - x2 * sin, x1 * sin + x2 * cos], axis=-1)


def axial_rope(x, tabs):
    cos_r, sin_r, cos_c, sin_c = tabs
    half = MLA_ROPE // 2
    out = jnp.concatenate([rotate(x[..., :half], cos_r, sin_r), rotate(x[..., half:], cos_c, sin_c)], axis=-1)
    return out.astype(x.dtype)


def gla_scan(q, k, v, log_f):
    B, L, H, DK = q.shape
    DV = v.shape[-1]
    n = L // HG_CHUNK

    def to_chunks(a):
        return a.astype(jnp.float32).reshape(B, n, HG_CHUNK, H, a.shape[-1]).transpose(1, 0, 3, 2, 4)

    mask = jnp.tril(jnp.ones((HG_CHUNK, HG_CHUNK), dtype=bool))[:, :, None]

    def step(S, inp):
        qc, kc, vc, gc = inp
        b = jnp.cumsum(gc, axis=2)
        inter = jnp.einsum('bhtk,bhkv->bhtv', qc * jnp.exp(b), S)
        diff = jnp.where(mask, b[:, :, :, None, :] - b[:, :, None, :, :], -jnp.inf)
        attn = jnp.einsum('bhtk,bhsk,bhtsk->bhts', qc, kc, jnp.exp(diff))
        intra = jnp.einsum('bhts,bhsv->bhtv', attn, vc)
        b_last = b[:, :, -1:, :]
        S_new = jnp.exp(b_last[:, :, 0, :])[..., None] * S + jnp.einsum('bhsk,bhsv->bhkv', kc * jnp.exp(b_last - b), vc)
        return S_new, inter + intra

    S0 = jnp.zeros((B, H, DK, DV), jnp.float32)
    _, o = lax.scan(step, S0, (to_chunks(q), to_chunks(k), to_chunks(v), to_chunks(log_f)))
    return o.transpose(1, 0, 3, 2, 4).reshape(B, L, H, DV)


def hgrn2_mixer(h_lat, h_ctx, w_in, gnorm_w, w_o, lower_bound, need_ctx):
    B, S, _ = h_lat.shape
    Lc = h_ctx.shape[1]
    L = Lc + S
    p = jnp.concatenate([h_ctx, h_lat], axis=1) @ w_in
    o1, o2, o3, o4 = HG_KW, 2 * HG_KW, 3 * HG_KW, 3 * HG_KW + HG_VW
    q = jax.nn.silu(p[..., :o1]).reshape(B, L, HG_HEADS, HG_DK)
    v = p[..., o3:o4].reshape(B, L, HG_HEADS, HG_DV)
    g = p[..., o4:]

    def gates(f_raw, lb):
        forget = lb + (1.0 - lb) * jax.nn.sigmoid(f_raw.astype(jnp.float32))
        shp = (B, L, HG_HEADS, HG_DK)
        return jnp.log(forget).reshape(shp), (1.0 - forget).reshape(shp)

    def flip_parts(a):
        return jnp.concatenate([jnp.flip(a[:, :Lc], axis=1), jnp.flip(a[:, Lc:], axis=1)], axis=1)

    logf_f, k_f = gates(p[..., o1:o2], lower_bound[0])
    logf_b, k_b = gates(p[..., o2:o3], lower_bound[1])
    o_fwd = gla_scan(q, k_f, v, logf_f)
    o_bwd = flip_parts(gla_scan(flip_parts(q), flip_parts(k_b), flip_parts(v), flip_parts(logf_b)))
    o = rms_norm(o_fwd + o_bwd, gnorm_w.reshape(HG_HEADS, HG_DV)).reshape(B, L, HG_VW)
    o = (o * jax.nn.silu(g.astype(jnp.float32))).astype(h_lat.dtype)
    y_lat = o[:, Lc:] @ w_o
    y_ctx = o[:, :Lc] @ w_o if need_ctx else None
    return y_lat, y_ctx


def mla_attend(qn, qp, kn, kp, v):
    s = jnp.einsum('bqhd,bkhd->bhqk', qn, kn) + jnp.einsum('bqhd,bkd->bhqk', qp, kp)
    p = jax.nn.softmax(s.astype(jnp.float32) * MLA_SCALE, axis=-1).astype(v.dtype)
    return jnp.einsum('bhqk,bkhd->bqhd', p, v)


def mla_mixer(h_lat, h_ctx, w_in, q_norm_w, kv_norm_w, w_uq, w_ukv, w_o, rope_tabs, need_ctx):
    B, S, _ = h_lat.shape
    Lc = h_ctx.shape[1]
    kv_cols = MLA_KV_RANK + MLA_ROPE

    def queries(cq):
        q = (rms_norm(cq, q_norm_w) @ w_uq).reshape(*cq.shape[:2], MLA_HEADS, MLA_NOPE + MLA_ROPE)
        return q[..., :MLA_NOPE], q[..., MLA_NOPE:]

    def keys_values(pkv):
        kv = (rms_norm(pkv[..., :MLA_KV_RANK], kv_norm_w) @ w_ukv).reshape(*pkv.shape[:2], MLA_HEADS, MLA_NOPE + MLA_V)
        return kv[..., :MLA_NOPE], kv[..., MLA_NOPE:], pkv[..., MLA_KV_RANK:]

    p_lat = h_lat @ w_in
    p_ctx = h_ctx @ (w_in if need_ctx else w_in[:, MLA_Q_RANK:])
    qn_l, qp_l = queries(p_lat[..., :MLA_Q_RANK])
    qp_l = axial_rope(qp_l, tuple(t[:, None, :] for t in rope_tabs))
    kn_l, v_l, kp_l = keys_values(p_lat[..., MLA_Q_RANK:])
    kp_l = axial_rope(kp_l, rope_tabs)
    kn_c, v_c, kp_c = keys_values(p_ctx[..., -kv_cols:])
    kn = jnp.concatenate([kn_c, kn_l], axis=1)
    kp = jnp.concatenate([kp_c, kp_l], axis=1)
    v = jnp.concatenate([v_c, v_l], axis=1)
    nblk = S // Q_BLOCK

    def to_blocks(a):
        return a.reshape(B, nblk, Q_BLOCK, *a.shape[2:]).swapaxes(0, 1)

    o_lat = lax.map(lambda qb: mla_attend(qb[0], qb[1], kn, kp, v), (to_blocks(qn_l), to_blocks(qp_l)))
    o_lat = o_lat.swapaxes(0, 1).reshape(B, S, MLA_HEADS * MLA_V)
    y_lat = o_lat @ w_o
    y_ctx = None
    if need_ctx:
        qn_c, qp_c = queries(p_ctx[..., :MLA_Q_RANK])
        o_ctx = mla_attend(qn_c, qp_c, kn_c, kp_c, v_c).reshape(B, Lc, MLA_HEADS * MLA_V)
        y_ctx = o_ctx @ w_o
    return y_lat, y_ctx


def moe_ffn(h, router_w, router_b, w_gu, b_gu, w_dn, b_dn):
    T = h.shape[0]
    n_assign = T * TOP_K
    logits = (h @ router_w + router_b).astype(jnp.float32)
    top_logit, top_e = lax.top_k(logits, TOP_K)
    gate = jax.nn.softmax(top_logit, axis=-1)
    e_flat = top_e.reshape(-1)
    tok_flat = jnp.arange(n_assign, dtype=jnp.int32) // TOP_K
    order = jnp.argsort(e_flat)
    e_sorted = e_flat[order]
    counts = jnp.bincount(e_flat, length=N_EXPERTS)
    padded = (counts + EXPERT_BLOCK - 1) // EXPERT_BLOCK * EXPERT_BLOCK
    start = jnp.cumsum(counts) - counts
    pad_end = jnp.cumsum(padded)
    pad_start = pad_end - padded
    dest = pad_start[e_sorted] + jnp.arange(n_assign, dtype=jnp.int32) - start[e_sorted]
    n_blocks = -(-n_assign // EXPERT_BLOCK) + N_EXPERTS
    n_rows = n_blocks * EXPERT_BLOCK
    row_tok = jnp.zeros((n_rows,), jnp.int32).at[dest].set(tok_flat[order])
    row_gate = jnp.zeros((n_rows,), jnp.float32).at[dest].set(gate.reshape(-1)[order])
    block_e = jnp.minimum(jnp.searchsorted(pad_end, jnp.arange(n_blocks, dtype=jnp.int32) * EXPERT_BLOCK, side='right'), N_EXPERTS - 1)

    def expert_block(args):
        tok, e = args
        gu = h[tok] @ w_gu[e] + b_gu[e]
        x_glu = jnp.minimum(gu[:, 0::2], SWIGLU_LIMIT)
        x_lin = jnp.clip(gu[:, 1::2], -SWIGLU_LIMIT, SWIGLU_LIMIT)
        act = x_glu * jax.nn.sigmoid(SWIGLU_ALPHA * x_glu) * (x_lin + 1.0)
        return act @ w_dn[e] + b_dn[e]

    y = lax.map(expert_block, (row_tok.reshape(n_blocks, EXPERT_BLOCK), block_e))
    y = y.reshape(n_rows, h.shape[-1]) * row_gate[:, None].astype(h.dtype)
    return jax.ops.segment_sum(y, row_tok, num_segments=T)


def setup_inputs(seed: int = 0) -> dict:
    key = jax.random.key(seed)
    ks = jax.random.split(key, 24)
    f32 = jnp.float32
    D = D_MODEL

    def nrm(k, shape, scale):
        return jax.random.normal(k, shape, f32) * scale

    return {
        'x': nrm(ks[0], (BATCH, SEQ, D), 1.0),
        'c': nrm(ks[1], (BATCH, D), 1.0),
        'ctx': nrm(ks[2], (BATCH, CTX_LEN, D), 1.0),
        'c_ctx': nrm(ks[3], (D,), 1.0),
        'ada_w': nrm(ks[4], (DEPTH, D, N_MOD * D), 0.2 * D ** -0.5),
        'ada_b': nrm(ks[5], (DEPTH, N_MOD * D), 0.02),
        'ln_g': 1.0 + nrm(ks[6], (DEPTH, 2, D), 0.02),
        'ln_b': nrm(ks[7], (DEPTH, 2, D), 0.02),
        'hg_w_in': nrm(ks[8], (N_HGRN_LAYERS, D, 3 * HG_KW + 2 * HG_VW), D ** -0.5),
        'hg_gnorm': 1.0 + nrm(ks[9], (N_HGRN_LAYERS, HG_VW), 0.02),
        'hg_lb_logits': nrm(ks[10], (DEPTH + 1, 2, HG_KW), 0.5),
        'hg_w_o': nrm(ks[11], (N_HGRN_LAYERS, HG_VW, D), HG_VW ** -0.5 * DEEPNORM_BETA),
        'mla_w_in': nrm(ks[12], (N_MLA_LAYERS, D, MLA_Q_RANK + MLA_KV_RANK + MLA_ROPE), D ** -0.5),
        'mla_q_norm': 1.0 + nrm(ks[13], (N_MLA_LAYERS, MLA_Q_RANK), 0.02),
        'mla_kv_norm': 1.0 + nrm(ks[14], (N_MLA_LAYERS, MLA_KV_RANK), 0.02),
        'mla_w_uq': nrm(ks[15], (N_MLA_LAYERS, MLA_Q_RANK, MLA_HEADS * (MLA_NOPE + MLA_ROPE)), MLA_Q_RANK ** -0.5),
        'mla_w_ukv': nrm(ks[16], (N_MLA_LAYERS, MLA_KV_RANK, MLA_HEADS * (MLA_NOPE + MLA_V)), MLA_KV_RANK ** -0.5),
        'mla_w_o': nrm(ks[17], (N_MLA_LAYERS, MLA_HEADS * MLA_V, D), (MLA_HEADS * MLA_V) ** -0.5 * DEEPNORM_BETA),
        'router_w': nrm(ks[18], (DEPTH, D, N_EXPERTS), D ** -0.5),
        'router_b': nrm(ks[19], (DEPTH, N_EXPERTS), 0.01),
        'exp_w_gu': nrm(ks[20], (DEPTH, N_EXPERTS, D, 2 * D_EXPERT), D ** -0.5),
        'exp_b_gu': nrm(ks[21], (DEPTH, N_EXPERTS, 2 * D_EXPERT), 0.02),
        'exp_w_dn': nrm(ks[22], (DEPTH, N_EXPERTS, D_EXPERT, D), D_EXPERT ** -0.5 * DEEPNORM_BETA),
        'exp_b_dn': nrm(ks[23], (DEPTH, N_EXPERTS, D), 0.02),
    }


def reference(x, c, ctx, c_ctx, ada_w, ada_b, ln_g, ln_b, hg_w_in, hg_gnorm, hg_lb_logits, hg_w_o,
              mla_w_in, mla_q_norm, mla_kv_norm, mla_w_uq, mla_w_ukv, mla_w_o,
              router_w, router_b, exp_w_gu, exp_b_gu, exp_w_dn, exp_b_dn):
    B, S, D = x.shape
    Lc = ctx.shape[1]
    rope_tabs = axial_rope_tables(S)
    lower_bounds = jnp.cumsum(jax.nn.softmax(hg_lb_logits.astype(jnp.float32), axis=0), axis=0)
    for i in range(DEPTH):
        need_ctx = i < DEPTH - 1
        j = i // N_MIXERS
        mod = (jax.nn.silu(c) @ ada_w[i] + ada_b[i]).reshape(B, 1, N_MOD, D)
        mod_c = (jax.nn.silu(c_ctx) @ ada_w[i] + ada_b[i]).reshape(N_MOD, D)
        h_lat = modulate(x, mod[:, :, 0], mod[:, :, 1])
        h_ctx = modulate(ctx, mod_c[0], mod_c[1])
        if i % N_MIXERS == 0:
            y_lat, y_ctx = hgrn2_mixer(h_lat, h_ctx, hg_w_in[j], hg_gnorm[j], hg_w_o[j], lower_bounds[i], need_ctx)
        else:
            y_lat, y_ctx = mla_mixer(h_lat, h_ctx, mla_w_in[j], mla_q_norm[j], mla_kv_norm[j], mla_w_uq[j],
                                     mla_w_ukv[j], mla_w_o[j], rope_tabs, need_ctx)
        x = post_norm(x, y_lat, mod[:, :, 2], ln_g[i, 0], ln_b[i, 0])
        h_tok = modulate(x, mod[:, :, 3], mod[:, :, 4]).reshape(B * S, D)
        if need_ctx:
            ctx = post_norm(ctx, y_ctx, mod_c[2], ln_g[i, 0], ln_b[i, 0])
            h_tok = jnp.concatenate([h_tok, modulate(ctx, mod_c[3], mod_c[4]).reshape(B * Lc, D)], axis=0)
        y = moe_ffn(h_tok, router_w[i], router_b[i], exp_w_gu[i], exp_b_gu[i], exp_w_dn[i], exp_b_dn[i])
        x = post_norm(x, y[:B * S].reshape(B, S, D), mod[:, :, 5], ln_g[i, 1], ln_b[i, 1])
        if need_ctx:
            ctx = post_norm(ctx, y[B * S:].reshape(B, Lc, D), mod_c[5], ln_g[i, 1], ln_b[i, 1])
    return x
```

```cpp
#include <hip/hip_runtime.h>
#include <stdio.h>
#include <stdint.h>

#ifndef MK_PER_PHASE
#define MK_PER_PHASE 0
#endif

#define LAS __attribute__((address_space(3)))
#define DI __device__ __forceinline__
typedef unsigned short bf16_t;
typedef short bf16x8 __attribute__((ext_vector_type(8)));
typedef short s16x4 __attribute__((ext_vector_type(4)));
typedef float f32x2 __attribute__((ext_vector_type(2)));
typedef float f32x4 __attribute__((ext_vector_type(4)));
typedef float f32x16 __attribute__((ext_vector_type(16)));
typedef unsigned u32x2 __attribute__((ext_vector_type(2)));
typedef unsigned u32x4 __attribute__((ext_vector_type(4)));
typedef __bf16 bfv2 __attribute__((ext_vector_type(2)));

typedef int v4i __attribute__((ext_vector_type(4)));
typedef int v8i __attribute__((ext_vector_type(8)));
constexpr float F8_WSCALE = 256.0f, F8_ASCALE = 8.0f, F8_WSCALE_DN = 512.0f, F8_ACTSCALE = 4.0f, F8_OGSCALE = 8.0f, F8_OSCALE = 32.0f;
DI float clamp8(float x) { return __builtin_amdgcn_fmed3f(x, -440.0f, 440.0f); }
DI unsigned pk8(float a, float b, float c, float d) { int w = __builtin_amdgcn_cvt_pk_fp8_f32(a, b, 0, false); w = __builtin_amdgcn_cvt_pk_fp8_f32(c, d, w, true); return (unsigned)w; }
DI unsigned pk(float a, float b) { f32x2 v = {a, b}; bfv2 r = __builtin_convertvector(v, bfv2); return __builtin_bit_cast(unsigned, r); }
DI float bf_lo(unsigned w) { return __uint_as_float(w << 16); }
DI float bf_hi(unsigned w) { return __uint_as_float(w & 0xffff0000u); }
DI float wave_sum(float v) { for (int o = 32; o >= 1; o >>= 1) v += __shfl_xor(v, o); return v; }
DI float sigm(float x) { return __builtin_amdgcn_rcpf(1.0f + __expf(-x)); }
DI int tid_() { int t = threadIdx.x; asm volatile("" : "+v"(t)); return t; }

constexpr int DM = 2048, NB = 4, SEQ = 4096, LC = 256, TL = NB * SEQ, TCX = NB * LC, T = TL + TCX, LSEQ = SEQ + LC;
constexpr int NE = 32, TCAP = T, HGN = 10240, MAXRT = 304, NMOD = 12288;
constexpr float DN_ALPHA = 1.4142135623730951f;
constexpr float LN_EPS = 1e-5f, RMS_EPS = 1e-6f;

constexpr size_t al256(size_t x) { return (x + 255) / 256 * 256; }
constexpr size_t WS_CTL = 0, CTL_BYTES = 65536;
constexpr size_t CTL_CNT0 = 16384, CTL_CNT1 = 24576;
constexpr size_t WS_MODV = WS_CTL + CTL_BYTES;
constexpr size_t WS_LB = WS_MODV + al256((size_t)2 * 5 * NMOD * 4);
constexpr size_t WS_ROPE = WS_LB + al256(2 * 2048 * 4);
constexpr size_t WS_WGU = WS_ROPE + al256(64 * 16 * 2 * 4);
constexpr size_t WS_WDN = WS_WGU + (size_t)2 * 32 * 4096 * 2048 * 2;
constexpr size_t WS_WHGIN = WS_WDN + (size_t)2 * 32 * 2048 * 2048 * 2;
constexpr size_t WS_WHGO = WS_WHGIN + (size_t)HGN * 2048 * 2;
constexpr size_t WS_WMIN = WS_WHGO + (size_t)2048 * 2048 * 2;
constexpr size_t WS_WUQ = WS_WMIN + (size_t)1280 * 2048 * 2;
constexpr size_t WS_WUKV = WS_WUQ + (size_t)3072 * 512 * 2;
constexpr size_t WS_WMO = WS_WUKV + (size_t)4096 * 512 * 2;
constexpr size_t WS_H = WS_WMO + (size_t)2048 * 2048 * 2;
constexpr size_t WS_P = WS_H + (size_t)T * 2048 * 2;
constexpr size_t WS_OF = WS_P + (size_t)T * HGN * 2;
constexpr size_t WS_OB = WS_OF + (size_t)T * 2048 * 2;
constexpr size_t WS_OG = WS_OB + (size_t)T * 2048 * 2;
constexpr size_t WS_Y = WS_OG + (size_t)T * 2048 * 2;
constexpr size_t WS_X1 = WS_Y + (size_t)T * 2048 * 2;
constexpr size_t WS_X2 = WS_X1 + (size_t)T * 2048 * 4;
constexpr size_t WS_H2 = WS_X2 + (size_t)T * 2048 * 4;
constexpr size_t WS_LTOK = WS_H2 + (size_t)T * 2048 * 2;
constexpr size_t WS_LGATE = WS_LTOK + al256((size_t)NE * TCAP * 4);
constexpr size_t WS_TOKES = WS_LGATE + al256((size_t)NE * TCAP * 4);
constexpr size_t WS_ACT = WS_TOKES + al256((size_t)T * 4 * 4);
constexpr size_t WS_Y2 = WS_ACT + (size_t)MAXRT * 256 * 2048 * 2;
constexpr size_t WS_PM = WS_Y2 + (size_t)MAXRT * 256 * 2048 * 2;
constexpr size_t WS_CQN = WS_PM + al256((size_t)T * 1088 * 4);
constexpr size_t WS_CKVN = WS_CQN + (size_t)TL * 512 * 2;
constexpr size_t WS_KP = WS_CKVN + (size_t)T * 512 * 2;
constexpr size_t WS_Q = WS_KP + (size_t)T * 64 * 2;
constexpr size_t WS_KV = WS_Q + (size_t)TL * 3072 * 2;
constexpr size_t WS_END = WS_KV + (size_t)T * 4096 * 2;

constexpr int RING_BYTES = 131072, TAB_OFF = 131072, TAB_BYTES = 24576, LCTL_OFF = TAB_OFF + TAB_BYTES, LDS_BYTES = LCTL_OFF + 1024;

#define XB_TMO      128
#define XB_XCNT(j)  (256  + 64 * (j))
#define XB_XSUB(j)  (1280 + 64 * (j))
#define XB_XGEN(j)  (2304 + 64 * (j))
#define XB_TOP      3328
#define XB_TOPGEN   3392
#define XCD_BAR_WORDS 3456
#define XB_SPIN_CAP (1u << 22)

__device__ __forceinline__ unsigned xb_ld(unsigned* p)              { return __hip_atomic_load(p, __ATOMIC_RELAXED, __HIP_MEMORY_SCOPE_AGENT); }
__device__ __forceinline__ unsigned xb_add(unsigned* p, unsigned v) { return __hip_atomic_fetch_add(p, v, __ATOMIC_RELAXED, __HIP_MEMORY_SCOPE_AGENT); }
__device__ __forceinline__ unsigned xb_xcc_id() { return (unsigned)__builtin_amdgcn_s_getreg((3 << 11) | 20) & 0xFu; }
#define XB_SPIN(cond, bar) do { unsigned _sp = 0; while (cond) { __builtin_amdgcn_s_sleep(1); \
    if ((++_sp & 255u) == 0u) { if (xb_ld(&(bar)[XB_TMO])) break; if (_sp > XB_SPIN_CAP) { atomicAdd(&(bar)[XB_TMO], 1u); break; } } } } while (0)

struct XcdBarrier { unsigned* bar; unsigned x; volatile LAS unsigned* st; };

__device__ __forceinline__ XcdBarrier xcd_barrier_post(unsigned* bar, volatile LAS unsigned* st) {
    XcdBarrier b; b.bar = bar; b.x = xb_xcc_id(); b.st = st;
    if (threadIdx.x == 0) (void)xb_add(&bar[XB_XCNT(b.x)], 1u);
    return b;
}
__device__ __forceinline__ void xcd_barrier_complete(unsigned* bar, unsigned x, unsigned& nloc, unsigned& nx) {
    const unsigned G = gridDim.x * gridDim.y * gridDim.z;
    unsigned sum, cnt, mine, sp = 0u;
    for (;;) {
        sum = 0u; cnt = 0u; mine = 0u;
#pragma unroll
        for (unsigned j = 0; j < 16; ++j) { const unsigned c = xb_ld(&bar[XB_XCNT(j)]); sum += c; cnt += (c > 0u) ? 1u : 0u; mine = (j == x) ? c : mine; }
        if (sum == G) break;
        __builtin_amdgcn_s_sleep(1);
        if ((++sp & 255u) == 0u) { if (xb_ld(&bar[XB_TMO])) break; if (sp > XB_SPIN_CAP) { atomicAdd(&bar[XB_TMO], 1u); break; } }
    }
    nloc = mine > 0u ? mine : 1u; nx = cnt > 0u ? cnt : 1u;
}
__device__ __forceinline__ void xcd_barrier(const XcdBarrier& b) {
    asm volatile("s_waitcnt vmcnt(0)" ::: "memory");
    __syncthreads();
    if (threadIdx.x == 0) {
        unsigned* bar = b.bar;
        __builtin_amdgcn_s_waitcnt(0);
        unsigned nloc = b.st[0], nx = b.st[1];
        if (nloc == 0u) { xcd_barrier_complete(bar, b.x, nloc, nx); b.st[0] = nloc; b.st[1] = nx; }
        const unsigned old = xb_add(&bar[XB_XSUB(b.x)], 1u);
        const unsigned gen = old / nloc;
        if (old + 1u == (gen + 1u) * nloc) {
            __builtin_amdgcn_fence(__ATOMIC_RELEASE, "agent");
            asm volatile("s_waitcnt vmcnt(0)" ::: "memory");
            const unsigned og = xb_add(&bar[XB_TOP], 1u);
            const unsigned tg = og / nx;
            if (og + 1u == (tg + 1u) * nx) xb_add(&bar[XB_TOPGEN], 1u);
            else XB_SPIN(xb_ld(&bar[XB_TOPGEN]) == tg, bar);
            __builtin_amdgcn_fence(__ATOMIC_ACQUIRE, "agent");
            xb_add(&bar[XB_XGEN(b.x)], 1u);
            asm volatile("s_waitcnt vmcnt(0)" ::: "memory");
        } else {
            XB_SPIN(xb_ld(&bar[XB_XGEN(b.x)]) == gen, bar);
            __builtin_amdgcn_fence(__ATOMIC_ACQUIRE, "agent");
            asm volatile("s_waitcnt vmcnt(0)" ::: "memory");
        }
    }
    __syncthreads();
}

namespace pg8 {
constexpr int BM = 256, BK = 64, HALF = 128, HTB = HALF * BK * 2, NXCD = 8, WGM = 8;
DI int lds_byte(int r, int c) { const int st = (r >> 4) * 2 + (c >> 5), rr = r & 15, cc = c & 31, ob = rr * 64 + cc * 2; return st * 1024 + (ob ^ (((ob >> 9) & 1) << 5)); }
DI void stage_rc(int b, int& R, int& C) { const int st = b / 1024, sb = b % 1024, swz = sb ^ (((sb >> 9) & 1) << 5); R = (st >> 1) * 16 + swz / 64; C = (st & 1) * 32 + (swz % 64) / 2; }
DI int perm32(int rho) { const int n = rho >> 4, i = rho & 15; return 8 * (i >> 2) + 4 * n + (i & 3); }

struct Unit { const char* B; int row0, col0, e, aux; };

template <bool FP8_ = false> struct PlainSched {
    static constexpr int RM = 256;
    int nM, nN, nwg, G, c, K; const char* Bt; unsigned* sig = nullptr;
    DI void init(int M, int N, int K_, const void* Bt_, int G_, int c_) { nM = M / RM; nN = N / BM; nwg = nM * nN; G = G_; c = c_; K = K_; Bt = (const char*)Bt_; }
    DI bool next(int i, Unit& u) const {
        const long L = (long)i * G + c; if (L >= nwg) return false;
        int wgid = (int)L; { const int q = nwg / NXCD, r = nwg % NXCD, xcd = wgid % NXCD, off = wgid / NXCD; wgid = (xcd < r ? xcd * (q + 1) : r * (q + 1) + (xcd - r) * q) + off; }
        const int nig = WGM * nN, gid = wgid / nig, fm = gid * WGM, gsz = (nM - fm) < WGM ? (nM - fm) : WGM;
        const int pm = fm + ((wgid % nig) % gsz), pn = (wgid % nig) / gsz;
        u.row0 = pm * RM; u.col0 = pn * BM; u.e = 0; u.aux = 0; u.B = Bt + (size_t)pn * BM * K * 2; return true;
    }
    static constexpr bool GATHER = false, FP8 = FP8_, HM = false;
    DI void avoff(int, const Unit&, const int (&)[2], const int (&)[2], unsigned (&)[2][2]) const {}
};
template <bool GATHER_, bool FP8_ = false> struct MoeSched {
    static constexpr bool GATHER = GATHER_, FP8 = FP8_, HM = false;
    static constexpr int RM = HM ? 128 : 256;
    const LAS int* tb; const LAS int* tb256; const LAS unsigned* offs; int NT, nunits, G, c, K, N; const char* Wt; unsigned* sig = nullptr;
    DI void init(const LAS int* tb_, const LAS int* tb256_, const LAS unsigned* offs_, int N_, int K_, const void* Wt_, int G_, int blk) {
        tb = tb_; tb256 = tb256_; offs = offs_; N = N_; K = K_; NT = N_ / BM; Wt = (const char*)Wt_; G = G_; nunits = tb_[32] * NT;
        { const int q = G_ / 8, r = G_ % 8, x = blk % 8; c = x * q + (x < r ? x : r) + blk / 8; }
    }
    DI bool next(int i, Unit& u) const {
        const int L = i * G + c; if (L >= nunits) return false;
        int rt = L / NT, pn = L - rt * NT;
        if (NT == 16 && L < 64 * (tb[32] >> 2)) { const int g = L >> 6, sub = L & 63; rt = 4 * g + ((sub & 31) >> 3); pn = (sub >> 5) * 8 + (sub & 7); }
        int e = 0;
#pragma unroll
        for (int st = 16; st >= 1; st >>= 1) e += (tb[e + st] <= rt) ? st : 0;
        e = __builtin_amdgcn_readfirstlane(e);
        u.e = e; u.aux = __builtin_amdgcn_readfirstlane((rt - tb[e]) * RM); u.row0 = __builtin_amdgcn_readfirstlane(tb256[e]) * BM + u.aux; u.col0 = pn * BM; u.B = Wt + ((size_t)e * N + (size_t)pn * BM) * K * 2; return true;
    }
    DI void avoff(int ui, const Unit&, const int (&R)[2], const int (&C)[2], unsigned (&vo)[2][2]) const {
#pragma unroll
        for (int h = 0; h < 2; ++h)
#pragma unroll
            for (int i = 0; i < 2; ++i) vo[h][i] = offs[ui * RM + (HM ? 0 : h * HALF) + R[i]] + (unsigned)C[i] * 2u;
    }
};

template <class Epi, class Sched>
DI void gemm_phase(LAS unsigned char* lds, const void* Abase_, int K, const Sched& S, const Epi& E) {
    const char* Abase = (const char*)Abase_;
    const int tid = tid_(), wid = __builtin_amdgcn_readfirstlane(tid >> 6), lane = tid & 63, wr = wid >> 2, wc = wid & 3, fr = lane & 15, fq = lane >> 4;
    const int nt = K / BK;
    int R[2], C[2]; unsigned voffB[2];
#pragma unroll
    for (int i = 0; i < 2; ++i) { stage_rc(tid * 16 + i * 8192, R[i], C[i]); const int Rb = (R[i] & ~31) + perm32(R[i] & 31); voffB[i] = (unsigned)(Rb * K + C[i]) * 2u; }
    const size_t kstep = (size_t)(BK * 2);
    const size_t hstep = (size_t)HALF * K * 2;
    const unsigned ldsw = (unsigned)wid * 1024u;
    const int aoff = lds_byte(wr * 64 + fr, fq * 8), boff = lds_byte(wc * 32 + fr, fq * 8);
#define PG8_SA(b, h) (((b) * 2 + (h)) * HTB)
#define PG8_SB(b, h) ((4 + (b) * 2 + (h)) * HTB)
#define PG8_STAGE(bufoff, gbase, voff) do { const char* gb_; { const unsigned long long t_ = (unsigned long long)(gbase); unsigned lo_ = __builtin_amdgcn_readfirstlane((unsigned)t_), hi_ = __builtin_amdgcn_readfirstlane((unsigned)(t_ >> 32)); \
        asm volatile("" : "+s"(lo_), "+s"(hi_)); gb_ = (const char*)(((unsigned long long)hi_ << 32) | lo_); }     \
        _Pragma("unroll") for (int _i = 0; _i < 2; ++_i) \
        __builtin_amdgcn_global_load_lds((const unsigned*)(gb_ + (voff)[_i]), (LAS unsigned*)(lds + (bufoff) + ldsw + _i * 8192), 16, 0, 0); } while (0)
#define PG8_LDA(dst, b, h) do { if constexpr (Sched::FP8) { const LAS unsigned char* p_ = lds + PG8_SA(b, h) + aoff; _Pragma("unroll") for (int m = 0; m < 4; ++m) \
            dst##8[m] = __builtin_shufflevector(*(const LAS v4i*)(p_ + m * 2048), *(const LAS v4i*)(p_ + m * 2048 + 1024), 0, 1, 2, 3, 4, 5, 6, 7); } \
        else { _Pragma("unroll") for (int m = 0; m < 4; ++m) _Pragma("unroll") for (int k = 0; k < 2; ++k) dst[m][k] = *(const LAS bf16x8*)(lds + PG8_SA(b, h) + aoff + m * 2048 + k * 1024); } } while (0)
#define PG8_LDB(dst, b, h) do { if constexpr (Sched::FP8) { const LAS unsigned char* p_ = lds + PG8_SB(b, h) + boff; _Pragma("unroll") for (int n = 0; n < 2; ++n) \
            dst##8[n] = __builtin_shufflevector(*(const LAS v4i*)(p_ + n * 2048), *(const LAS v4i*)(p_ + n * 2048 + 1024), 0, 1, 2, 3, 4, 5, 6, 7); } \
        else { _Pragma("unroll") for (int n = 0; n < 2; ++n) _Pragma("unroll") for (int k = 0; k < 2; ++k) dst[n][k] = *(const LAS bf16x8*)(lds + PG8_SB(b, h) + boff + n * 2048 + k * 1024); } } while (0)
#define PG8_MMA(ai, bj, At, Bt) do { __builtin_amdgcn_s_setprio(1); \
        if constexpr (Sched::FP8) { _Pragma("unroll") for (int m = 0; m < 4; ++m) _Pragma("unroll") for (int n = 0; n < 2; ++n) \
            acc[ai][bj][m][n] = __builtin_amdgcn_mfma_scale_f32_16x16x128_f8f6f4(Bt##8[n], At##8[m], acc[ai][bj][m][n], 0, 0, 0, 0, 0, 0); } \
        else { _Pragma("unroll") for (int m = 0; m < 4; ++m) _Pragma("unroll") for (int n = 0; n < 2; ++n) _Pragma("unroll") for (int k = 0; k < 2; ++k) \
            acc[ai][bj][m][n] = __builtin_amdgcn_mfma_f32_16x16x32_bf16(Bt[n][k], At[m][k], acc[ai][bj][m][n], 0, 0, 0); } \
        __builtin_amdgcn_s_setprio(0); } while (0)
#define PG8_MMAZ(ai, bj, At, Bt, zc) do { __builtin_amdgcn_s_setprio(1); \
        if (zc) { const f32x4 z_ = {0.f, 0.f, 0.f, 0.f}; _Pragma("unroll") for (int m = 0; m < 4; ++m) _Pragma("unroll") for (int n = 0; n < 2; ++n) \
            acc[ai][bj][m][n] = __builtin_amdgcn_mfma_scale_f32_16x16x128_f8f6f4(Bt##8[n], At##8[m], z_, 0, 0, 0, 0, 0, 0); }     \
        else { _Pragma("unroll") for (int m = 0; m < 4; ++m) _Pragma("unroll") for (int n = 0; n < 2; ++n) \
            acc[ai][bj][m][n] = __builtin_amdgcn_mfma_scale_f32_16x16x128_f8f6f4(Bt##8[n], At##8[m], acc[ai][bj][m][n], 0, 0, 0, 0, 0, 0); } \
        __builtin_amdgcn_s_setprio(0); } while (0)
#define PG8_WAIT_V(n) asm volatile("s_waitcnt vmcnt(" #n ")" ::: "memory")
#define PG8_WAIT_L(n) asm volatile("s_waitcnt lgkmcnt(" #n ")" ::: "memory")
#define PG8_BAR __builtin_amdgcn_s_barrier()
#define PG8_SCHED __builtin_amdgcn_sched_barrier(0)
    Unit cur, nxt; int ui = 0;
    if (!S.next(0, cur)) return;
    f32x4 acc[2][2][4][2];
#pragma unroll
    for (int a = 0; a < 2; ++a)
#pragma unroll
        for (int b = 0; b < 2; ++b)
#pragma unroll
            for (int m = 0; m < 4; ++m)
#pragma unroll
                for (int n = 0; n < 2; ++n) acc[a][b][m][n] = (f32x4){0.f, 0.f, 0.f, 0.f};
    bf16x8 At[4][2], B0[2][2], B1[2][2];
    v8i At8[4], B08[2], B18[2];
    constexpr bool GA = Sched::GATHER, HM = Sched::HM;
    unsigned voffA[2];
#pragma unroll
    for (int i = 0; i < 2; ++i) voffA[i] = (unsigned)(R[i] * K + C[i]) * 2u;
    unsigned cvo[2][2];
    if constexpr (GA) S.avoff(0, cur, R, C, cvo);
    const size_t tstepA = (size_t)K * 2;
    const char* cA = GA ? Abase : Abase + (size_t)cur.row0 * tstepA;
    const char* cB = cur.B;
#define PG8_STAGE_A(bufoff, ab, vo, h, kb) do { if constexpr (GA) { PG8_STAGE(bufoff, Abase + (kb), (vo)[h]); } else { PG8_STAGE(bufoff, (ab) + (size_t)(h) * hstep + (kb), voffA); } } while (0)
    if constexpr (HM) {
        PG8_STAGE(PG8_SB(0, 0), cB, voffB); PG8_STAGE_A(PG8_SA(0, 0), cA, cvo, 0, 0); PG8_STAGE(PG8_SB(0, 1), cB + hstep, voffB);
        if (wr == 1) PG8_BAR;
        PG8_WAIT_V(0); PG8_BAR;
        PG8_STAGE(PG8_SB(1, 0), cB + kstep, voffB); PG8_STAGE_A(PG8_SA(1, 0), cA, cvo, 0, kstep);
        PG8_WAIT_V(6); PG8_BAR;
    } else if constexpr (Sched::FP8) {
        PG8_STAGE_A(PG8_SA(0, 0), cA, cvo, 0, 0); PG8_STAGE(PG8_SB(0, 1), cB + hstep, voffB); PG8_STAGE_A(PG8_SA(0, 1), cA, cvo, 1, 0); PG8_STAGE(PG8_SB(0, 0), cB, voffB);
        PG8_STAGE_A(PG8_SA(1, 0), cA, cvo, 0, kstep); PG8_STAGE(PG8_SB(1, 1), cB + hstep + kstep, voffB); PG8_STAGE_A(PG8_SA(1, 1), cA, cvo, 1, kstep);
        if (wr == 1) PG8_BAR;
        PG8_WAIT_V(6); PG8_BAR; PG8_BAR;
    } else {
        PG8_STAGE(PG8_SB(0, 0), cB, voffB); PG8_STAGE(PG8_SB(0, 1), cB + hstep, voffB); PG8_STAGE_A(PG8_SA(0, 0), cA, cvo, 0, 0); PG8_STAGE_A(PG8_SA(0, 1), cA, cvo, 1, 0);
        if (wr == 1) PG8_BAR;
        PG8_WAIT_V(2); PG8_BAR;
        PG8_STAGE(PG8_SB(1, 0), cB + kstep, voffB); PG8_STAGE_A(PG8_SA(1, 0), cA, cvo, 0, kstep); PG8_STAGE(PG8_SB(1, 1), cB + hstep + kstep, voffB);
        PG8_WAIT_V(6); PG8_BAR;
    }
    for (;;) {
        const bool has_next = S.next(ui + 1, nxt);
        if (!has_next && S.sig != nullptr && blockIdx.x == 0 && threadIdx.x == 0) __hip_atomic_fetch_add(S.sig, 1u, __ATOMIC_RELAXED, __HIP_MEMORY_SCOPE_AGENT);
        const char* nB = has_next ? nxt.B : cB;
        const char* nA = GA ? Abase : (has_next ? Abase + (size_t)nxt.row0 * tstepA : cA);
        for (int t = 0; t < nt; t += 2) {
            const bool last = (t == nt - 2);
            const size_t k1 = (size_t)(t + 1) * kstep, k2 = last ? 0 : (size_t)(t + 2) * kstep, k3 = k2 + kstep;
            const char* a2 = last ? nA : cA; const char* b2 = (last ? nB : cB) + k2; const char* b3 = b2 + kstep;
            unsigned v2[2][2];
            if constexpr (GA) {
                if (last && has_next) S.avoff(ui + 1, nxt, R, C, v2);
                else {
#pragma unroll
                    for (int h = 0; h < 2; ++h)
#pragma unroll
                        for (int i = 0; i < 2; ++i) v2[h][i] = cvo[h][i];
                }
            }
            if constexpr (HM) {
            PG8_LDB(B0, 0, 0); PG8_SCHED; PG8_LDA(At, 0, 0); PG8_STAGE(PG8_SB(1, 1), cB + hstep + k1, voffB);
            PG8_WAIT_V(6); PG8_WAIT_L(0); PG8_BAR; PG8_MMA(0, 0, At, B0); PG8_BAR; PG8_SCHED;
            PG8_LDB(B1, 0, 1); PG8_STAGE(PG8_SB(0, 0), b2, voffB); PG8_STAGE_A(PG8_SA(0, 0), a2, v2, 0, k2);
            PG8_WAIT_V(6); PG8_WAIT_L(0); PG8_BAR; PG8_MMA(0, 1, At, B1); PG8_BAR; PG8_SCHED;
            PG8_LDB(B0, 1, 0); PG8_SCHED; PG8_LDA(At, 1, 0); PG8_STAGE(PG8_SB(0, 1), b2 + hstep, voffB);
            PG8_WAIT_V(6); PG8_WAIT_L(0); PG8_BAR; PG8_MMA(0, 0, At, B0); PG8_BAR; PG8_SCHED;
            PG8_LDB(B1, 1, 1); PG8_STAGE(PG8_SB(1, 0), b3, voffB); PG8_STAGE_A(PG8_SA(1, 0), a2, v2, 0, k3);
            PG8_WAIT_V(6); PG8_WAIT_L(0); PG8_BAR; PG8_MMA(0, 1, At, B1); PG8_BAR; PG8_SCHED;
            } else if constexpr (Sched::FP8) {
#define F8_KTILE(b, sB0n, aX, vX, kX, sB1x, zc) \
            PG8_LDB(B0, b, 0); PG8_SCHED; PG8_LDA(At, b, 0); PG8_STAGE(PG8_SB(1 - (b), 0), sB0n, voffB); \
            PG8_WAIT_V(12); PG8_WAIT_L(0); PG8_BAR; PG8_MMAZ(0, 0, At, B0, zc); PG8_BAR; PG8_SCHED; \
            PG8_LDB(B1, b, 1); PG8_STAGE_A(PG8_SA(b, 0), aX, vX, 0, kX); \
            PG8_WAIT_V(12); PG8_WAIT_L(0); PG8_BAR; PG8_MMAZ(0, 1, At, B1, zc); PG8_BAR; PG8_SCHED; \
            PG8_LDA(At, b, 1); PG8_STAGE(PG8_SB(b, 1), sB1x, voffB); \
            PG8_WAIT_V(12); PG8_WAIT_L(0); PG8_BAR; PG8_MMAZ(1, 1, At, B1, zc); PG8_BAR; PG8_SCHED; \
            PG8_LDB(B0, b, 0); PG8_STAGE_A(PG8_SA(b, 1), aX, vX, 1, kX); \
            PG8_WAIT_V(6); PG8_WAIT_L(0); PG8_BAR; PG8_MMAZ(1, 0, At, B0, zc); PG8_BAR; PG8_SCHED;
            F8_KTILE(0, cB + k1, a2, v2, k2, b2 + hstep, (t == 0))
            F8_KTILE(1, b2, a2, v2, k3, b3 + hstep, false)
#undef F8_KTILE
            } else {
            PG8_LDB(B0, 0, 0); PG8_LDB(B1, 0, 1); PG8_SCHED; PG8_LDA(At, 0, 0); PG8_STAGE_A(PG8_SA(1, 1), cA, cvo, 1, k1);
            PG8_WAIT_V(8); PG8_WAIT_L(0); PG8_BAR; PG8_MMA(0, 0, At, B0); PG8_MMA(0, 1, At, B1); PG8_BAR; PG8_SCHED;
            PG8_LDA(At, 0, 1); PG8_STAGE(PG8_SB(0, 0), b2, voffB); PG8_STAGE(PG8_SB(0, 1), b2 + hstep, voffB); PG8_STAGE_A(PG8_SA(0, 0), a2, v2, 0, k2);
            PG8_WAIT_V(8); PG8_WAIT_L(0); PG8_BAR; PG8_MMA(1, 0, At, B0); PG8_MMA(1, 1, At, B1); PG8_BAR; PG8_SCHED;
            PG8_LDB(B0, 1, 0); PG8_LDB(B1, 1, 1); PG8_SCHED; PG8_LDA(At, 1, 0); PG8_STAGE_A(PG8_SA(0, 1), a2, v2, 1, k2);
            PG8_WAIT_V(8); PG8_WAIT_L(0); PG8_BAR; PG8_MMA(0, 0, At, B0); PG8_MMA(0, 1, At, B1); PG8_BAR; PG8_SCHED;
            PG8_LDA(At, 1, 1); PG8_STAGE(PG8_SB(1, 0), b3, voffB); PG8_STAGE(PG8_SB(1, 1), b3 + hstep, voffB); PG8_STAGE_A(PG8_SA(1, 0), a2, v2, 0, k3);
            PG8_WAIT_V(8); PG8_WAIT_L(0); PG8_BAR; PG8_MMA(1, 0, At, B0); PG8_MMA(1, 1, At, B1); PG8_BAR; PG8_SCHED;
            }
            if constexpr (GA) { if (last) {
#pragma unroll
                for (int h = 0; h < 2; ++h)
#pragma unroll
                    for (int i = 0; i < 2; ++i) cvo[h][i] = v2[h][i]; } }
        }
        if (wr == 0) PG8_BAR;
        { const int l2_ = tid_() & 63; E(acc, cur, wr, wc, l2_ & 15, l2_ >> 4); }
#ifdef MK_EPI2
        E(acc, cur, wr, wc, fr, fq);
#endif
        if (!has_next) break;
        if constexpr (!(Sched::FP8 && !HM)) {
#pragma unroll
        for (int a = 0; a < 2; ++a)
#pragma unroll
            for (int b = 0; b < 2; ++b)
#pragma unroll
                for (int m = 0; m < 4; ++m)
#pragma unroll
                    for (int n = 0; n < 2; ++n) acc[a][b][m][n] = (f32x4){0.f, 0.f, 0.f, 0.f};
        }
        cur = nxt; cB = nB; cA = nA; ++ui;
        if (wr == 1) PG8_BAR;
    }
    PG8_WAIT_V(0);
    PG8_BAR;
#undef PG8_SA
#undef PG8_SB
#undef PG8_STAGE
#undef PG8_STAGE_A
#undef PG8_LDA
#undef PG8_LDB
#undef PG8_MMA
#undef PG8_MMAZ
#undef PG8_WAIT_V
#undef PG8_WAIT_L
#undef PG8_BAR
#undef PG8_SCHED
}

#define EPI_LOOP_BEGIN \
    _Pragma("unroll") for (int bj = 0; bj < 2; ++bj) { const int c0 = u.col0 + bj * HALF + wc * 32 + 8 * fq; (void)c0;
#define EPI_ROWS_BEGIN \
    _Pragma("unroll") for (int ai = 0; ai < NAI; ++ai) _Pragma("unroll") for (int m = 0; m < 4; ++m) { const int lr = ai * HALF + wr * 64 + m * 16 + fr; const int row = u.row0 + lr; (void)row; \
        float v[8]; { const f32x4 v0 = acc[ai][bj][m][0], v1 = acc[ai][bj][m][1]; v[0] = v0[0]; v[1] = v0[1]; v[2] = v0[2]; v[3] = v0[3]; v[4] = v1[0]; v[5] = v1[1]; v[6] = v1[2]; v[7] = v1[3]; }
#define EPI_END } }

template <bool HM_ = false> struct EpiBf16 {
    static constexpr int NAI = HM_ ? 1 : 2;
    bf16_t* O; int ld, ncols; float sc;
    DI void operator()(const f32x4 (&acc)[2][2][4][2], const Unit& u, int wr, int wc, int fr, int fq) const {
        EPI_LOOP_BEGIN
            if (c0 < ncols) {
        EPI_ROWS_BEGIN
                u32x4 w; w.x = pk(v[0] * sc, v[1] * sc); w.y = pk(v[2] * sc, v[3] * sc); w.z = pk(v[4] * sc, v[5] * sc); w.w = pk(v[6] * sc, v[7] * sc);
                *(u32x4*)(O + (size_t)row * ld + c0) = w;
            } }
        }
    }
};
struct EpiF32 {
    static constexpr int NAI = 2;
    float* O; int ld, ncols;
    DI void operator()(const f32x4 (&acc)[2][2][4][2], const Unit& u, int wr, int wc, int fr, int fq) const {
        EPI_LOOP_BEGIN
            if (c0 < ncols) {
        EPI_ROWS_BEGIN
                float* p = O + (size_t)row * ld + c0;
                *(f32x4*)p = (f32x4){v[0], v[1], v[2], v[3]}; *(f32x4*)(p + 4) = (f32x4){v[4], v[5], v[6], v[7]};
            } }
        }
    }
};
struct EpiHgIn {
    static constexpr int NAI = 2;
    bf16_t* P; const float* lb; float sc;
    DI void operator()(const f32x4 (&acc)[2][2][4][2], const Unit& u, int wr, int wc, int fr, int fq) const {
        const int sec = u.col0 >> 11;
        EPI_LOOP_BEGIN
            float lbv[8];
#pragma unroll
            for (int j = 0; j < 8; ++j) lbv[j] = 0.f;
            if (sec == 1 || sec == 2) { const float* lp = lb + (sec - 1) * 2048 + (c0 & 2047); const f32x4 l0 = *(const f32x4*)lp, l1 = *(const f32x4*)(lp + 4);
                lbv[0] = l0[0]; lbv[1] = l0[1]; lbv[2] = l0[2]; lbv[3] = l0[3]; lbv[4] = l1[0]; lbv[5] = l1[1]; lbv[6] = l1[2]; lbv[7] = l1[3]; }
        EPI_ROWS_BEGIN
#pragma unroll
            for (int j = 0; j < 8; ++j) v[j] *= sc;
            if (sec == 0 || sec == 4) {
#pragma unroll
                for (int j = 0; j < 8; ++j) v[j] = v[j] * sigm(v[j]);
            } else if (sec == 1 || sec == 2) {
#pragma unroll
                for (int j = 0; j < 8; ++j) v[j] = __logf(lbv[j] + (1.0f - lbv[j]) * sigm(v[j]));
            }
            u32x4 w; w.x = pk(v[0], v[1]); w.y = pk(v[2], v[3]); w.z = pk(v[4], v[5]); w.w = pk(v[6], v[7]);
            *(u32x4*)(P + (size_t)row * HGN + c0) = w;
        EPI_END
    }
};
template <bool HM_, bool ACT8_ = HM_> struct EpiGU {
    static constexpr int NAI = HM_ ? 1 : 2;
    bf16_t* act; const float* bgu; float sc;
    DI void operator()(const f32x4 (&acc)[2][2][4][2], const Unit& u, int wr, int wc, int fr, int fq) const {
        EPI_LOOP_BEGIN
            const float* bp = bgu + (size_t)u.e * 4096 + c0; const f32x4 b0 = *(const f32x4*)bp, b1 = *(const f32x4*)(bp + 4);
        EPI_ROWS_BEGIN
            const float x0 = fminf(v[0] * sc + b0[0], 7.f), l0 = fminf(fmaxf(v[1] * sc + b0[1], -7.f), 7.f);
            const float x1 = fminf(v[2] * sc + b0[2], 7.f), l1 = fminf(fmaxf(v[3] * sc + b0[3], -7.f), 7.f);
            const float x2 = fminf(v[4] * sc + b1[0], 7.f), l2 = fminf(fmaxf(v[5] * sc + b1[1], -7.f), 7.f);
            const float x3 = fminf(v[6] * sc + b1[2], 7.f), l3 = fminf(fmaxf(v[7] * sc + b1[3], -7.f), 7.f);
            const float a0 = x0 * sigm(1.702f * x0) * (l0 + 1.f), a1 = x1 * sigm(1.702f * x1) * (l1 + 1.f);
            const float a2 = x2 * sigm(1.702f * x2) * (l2 + 1.f), a3 = x3 * sigm(1.702f * x3) * (l3 + 1.f);
            if constexpr (ACT8_) *(unsigned*)((unsigned char*)act + (size_t)row * 2048 + (c0 >> 1)) = pk8(a0 * F8_ACTSCALE, a1 * F8_ACTSCALE, a2 * F8_ACTSCALE, a3 * F8_ACTSCALE);
            else { u32x2 w; w.x = pk(a0, a1); w.y = pk(a2, a3); *(u32x2*)(act + (size_t)row * 2048 + (c0 >> 1)) = w; }
        EPI_END
    }
};
template <bool HM_> struct EpiDN {
    static constexpr int NAI = HM_ ? 1 : 2;
    bf16_t* y2; const float* bdn; const float* lgate; const LAS int* cn; float sc;
    DI void operator()(const f32x4 (&acc)[2][2][4][2], const Unit& u, int wr, int wc, int fr, int fq) const {
        const int cnt = cn[u.e];
        EPI_LOOP_BEGIN
            const float* bp = bdn + (size_t)u.e * 2048 + c0; const f32x4 b0 = *(const f32x4*)bp, b1 = *(const f32x4*)(bp + 4);
        EPI_ROWS_BEGIN
            const int slot = u.aux + lr;
            const float g = slot < cnt ? lgate[(size_t)u.e * TCAP + slot] : 0.f;
            u32x4 w; w.x = pk((v[0] * sc + b0[0]) * g, (v[1] * sc + b0[1]) * g); w.y = pk((v[2] * sc + b0[2]) * g, (v[3] * sc + b0[3]) * g);
            w.z = pk((v[4] * sc + b1[0]) * g, (v[5] * sc + b1[1]) * g); w.w = pk((v[6] * sc + b1[2]) * g, (v[7] * sc + b1[3]) * g);
            *(u32x4*)(y2 + (size_t)row * 2048 + c0) = w;
        EPI_END
    }
};
}

struct Args { const float* in[24]; float* out; unsigned char* ws; int ph_lo, ph_hi; };
enum { I_X = 0, I_C, I_CTX, I_CCTX, I_ADAW, I_ADAB, I_LNG, I_LNB, I_HGWIN, I_HGGN, I_HGLB, I_HGWO, I_MWIN, I_MQN, I_MKVN, I_MWUQ, I_MWUKV, I_MWO, I_RW, I_RB, I_WGU, I_BGU, I_WDN, I_BDN };

namespace cvq {
constexpr int E0 = 1280, E1 = 1536, E2 = 17920, E3 = 26112, E4 = 26256, E5 = 26352, E6 = 26480, E7 = 26736, E8 = 43120, TOTAL = 51312, BATCH = 8;
constexpr int CV_NEXT = 8192, CV_DONE0 = 8256;
DI int need(int p) { return p < 2 ? 0 : p < 5 ? E0 : p < 7 ? E1 : p < 8 ? E2 : p < 10 ? E3 : p < 12 ? E4 : p < 14 ? E6 : p < 16 ? E7 : p < 17 ? E8 : TOTAL; }
struct Tile { const float* sp; bf16_t* dp; int K, N, ncol0, f8; };
DI void decode(const Args& a, int t, Tile& x) {
    unsigned char* ws = a.ws;
    const float* src; bf16_t* dst; int K, N, nmat_per; size_t ss, ds; int loc; int f8 = 0;
    if (t < E0)      { src = a.in[I_HGWIN]; dst = (bf16_t*)(ws + WS_WHGIN); K = 2048; N = HGN;  ss = 0; ds = 0; loc = t; f8 = 1; }
    else if (t < E1) { src = a.in[I_HGWO];  dst = (bf16_t*)(ws + WS_WHGO);  K = 2048; N = 2048; ss = 0; ds = 0; loc = t - E0; f8 = 2; }
    else if (t < E2) { src = a.in[I_WGU];   dst = (bf16_t*)(ws + WS_WGU);   K = 2048; N = 4096; ss = (size_t)2048 * 4096; ds = ss; loc = t - E1; f8 = 1; }
    else if (t < E3) { src = a.in[I_WDN];   dst = (bf16_t*)(ws + WS_WDN);   K = 2048; N = 2048; ss = (size_t)2048 * 2048; ds = ss; loc = t - E2; f8 = 2; }
    else if (t < E4) { src = a.in[I_MWIN];  dst = (bf16_t*)(ws + WS_WMIN);  K = 2048; N = 1088; ss = 0; ds = 0; loc = t - E3; }
    else if (t < E5) { src = a.in[I_MWUQ];  dst = (bf16_t*)(ws + WS_WUQ);   K = 512;  N = 3072; ss = 0; ds = 0; loc = t - E4; }
    else if (t < E6) { src = a.in[I_MWUKV]; dst = (bf16_t*)(ws + WS_WUKV);  K = 512;  N = 4096; ss = 0; ds = 0; loc = t - E5; }
    else if (t < E7) { src = a.in[I_MWO];   dst = (bf16_t*)(ws + WS_WMO);   K = 2048; N = 2048; ss = 0; ds = 0; loc = t - E6; f8 = 2; }
    else if (t < E8) { src = a.in[I_WGU] + (size_t)32 * 2048 * 4096; dst = (bf16_t*)(ws + WS_WGU) + (size_t)32 * 2048 * 4096; K = 2048; N = 4096; ss = (size_t)2048 * 4096; ds = ss; loc = t - E7; f8 = 1; }
    else             { src = a.in[I_WDN] + (size_t)32 * 2048 * 2048; dst = (bf16_t*)(ws + WS_WDN) + (size_t)32 * 2048 * 2048; K = 2048; N = 2048; ss = (size_t)2048 * 2048; ds = ss; loc = t - E8; f8 = 2; }
    (void)nmat_per;
    const int ntiles = (N + 127) / 128, ktiles = K / 128, per = ktiles * ntiles, mat = loc / per, rem = loc - mat * per, ntl = rem / ktiles, kt = rem - ntl * ktiles;
    x.K = K; x.N = N; x.ncol0 = ntl * 128;
    x.sp = src + (size_t)mat * ss + (size_t)(kt * 128) * N + ntl * 128;
    x.dp = dst + (size_t)mat * ds + (size_t)(ntl * 128) * K + kt * 128; x.f8 = f8;
    if (f8) x.dp = (bf16_t*)((unsigned char*)dst + (size_t)mat * ds + (size_t)(ntl * 128) * K + kt * 128);
}
DI void load_tile(const Tile& x, int n4, int kr, f32x4 (&rg)[8]) {
    int nc = n4 * 4; { const int lim = x.N - x.ncol0 - 4; nc = nc < lim ? nc : lim; }
    const float* sp = x.sp + (size_t)kr * x.N + nc;
#pragma unroll
    for (int i = 0; i < 8; ++i) rg[i] = __builtin_nontemporal_load((const f32x4*)(sp + (size_t)(16 * i) * x.N));
}
DI void out_tile(const Tile& cur, LAS float* tile, int k8, int ng) {
    f32x4 v[8];
#pragma unroll
    for (int i = 0; i < 8; ++i) v[i] = *(const LAS f32x4*)(tile + (8 * k8 + i) * 128 + 4 * (ng ^ k8));
    if (cur.f8) {
        unsigned char* dp = (unsigned char*)cur.dp + (size_t)(4 * ng) * cur.K + 8 * k8; const float ws_ = cur.f8 == 1 ? F8_WSCALE : F8_WSCALE_DN;
#pragma unroll
        for (int j = 0; j < 4; ++j) {
            u32x2 w; w.x = pk8(v[0][j] * ws_, v[1][j] * ws_, v[2][j] * ws_, v[3][j] * ws_); w.y = pk8(v[4][j] * ws_, v[5][j] * ws_, v[6][j] * ws_, v[7][j] * ws_);
            __builtin_nontemporal_store(w, (u32x2*)(dp + (size_t)j * cur.K));
        }
    } else if (cur.ncol0 + 4 * ng < cur.N) {
        bf16_t* dp = cur.dp + (size_t)(4 * ng) * cur.K + 8 * k8;
#pragma unroll
        for (int j = 0; j < 4; ++j) {
            u32x4 w; w.x = pk(v[0][j], v[1][j]); w.y = pk(v[2][j], v[3][j]); w.z = pk(v[4][j], v[5][j]); w.w = pk(v[6][j], v[7][j]);
            __builtin_nontemporal_store(w, (u32x4*)(dp + (size_t)j * cur.K));
        }
    }
}
DI void batch(const Args& a, int t0, LAS unsigned char* lds) {
    constexpr int nb = BATCH;
    LAS float* tile = (LAS float*)lds;
    const int tid = tid_(), n4 = tid & 31, kr = tid >> 5, k8 = tid & 15, ng = tid >> 4;
    f32x4 rgA[8], rgB[8]; Tile tA, tB, tn;
    decode(a, t0, tA); load_tile(tA, n4, kr, rgA);
    decode(a, t0 + 1, tB); load_tile(tB, n4, kr, rgB);
#define CV_PUT(RG) _Pragma("unroll") for (int i = 0; i < 8; ++i) *(LAS f32x4*)(tile + (kr + 16 * i) * 128 + 4 * (n4 ^ (((kr >> 3) + 2 * i) & 15))) = RG[i]
#pragma unroll
    for (int j = 0; j < nb; j += 2) {
        CV_PUT(rgA);
        __syncthreads();
        if (j + 2 < nb) { decode(a, t0 + j + 2, tn); load_tile(tn, n4, kr, rgA); }
        out_tile(tA, tile, k8, ng);
        __syncthreads();
        tA = tn;
        CV_PUT(rgB);
        __syncthreads();
        if (j + 3 < nb) { decode(a, t0 + j + 3, tn); load_tile(tn, n4, kr, rgB); }
        out_tile(tB, tile, k8, ng);
        __syncthreads();
        tB = tn;
    }
#undef CV_PUT
}
DI void service(const Args& a, LAS unsigned char* lds, int mandatory, unsigned* done_word, unsigned done_target) {
    unsigned* nextw = (unsigned*)(a.ws + WS_CTL) + CV_NEXT;
    volatile LAS int* slot = (volatile LAS int*)(lds + LCTL_OFF + 512);
    for (;;) {
        __syncthreads();
        if (threadIdx.x == 0) {
            int t0 = -1; const unsigned curv = __hip_atomic_load(nextw, __ATOMIC_RELAXED, __HIP_MEMORY_SCOPE_AGENT);
            bool go = curv < (unsigned)TOTAL && (curv < (unsigned)mandatory || (done_word != nullptr && __hip_atomic_load(done_word, __ATOMIC_RELAXED, __HIP_MEMORY_SCOPE_AGENT) < done_target));
            if (go) { t0 = (int)__hip_atomic_fetch_add(nextw, (unsigned)BATCH, __ATOMIC_RELAXED, __HIP_MEMORY_SCOPE_AGENT); if (t0 >= TOTAL) t0 = -1; }
            slot[0] = t0;
        }
        __syncthreads();
        const int t0 = slot[0];
        if (t0 < 0) break;
        batch(a, t0, lds);
    }
}
DI void signal_done(const Args& a, int p) {
    asm volatile("s_waitcnt vmcnt(0)" ::: "memory"); __syncthreads();
    if (threadIdx.x == 0) __hip_atomic_fetch_add((unsigned*)(a.ws + WS_CTL) + CV_DONE0 + 64 * p, 1u, __ATOMIC_RELAXED, __HIP_MEMORY_SCOPE_AGENT);
}
DI unsigned* done_word(const Args& a, int p) { return (unsigned*)(a.ws + WS_CTL) + CV_DONE0 + 64 * p; }
}

DI void p0_prologue(const Args& a, LAS unsigned char* lds, int G) {
    const int tid = tid_();
    unsigned char* ws = a.ws;
    if ((int)blockIdx.x < 192) {
        LAS float* sc = (LAS float*)lds;
        LAS float* red = (LAS float*)(lds + 40960);
        for (int idx = tid; idx < 5 * 2048; idx += 512) { const int r = idx >> 11, k = idx & 2047; const float v = r < 4 ? a.in[I_C][r * 2048 + k] : a.in[I_CCTX][k]; sc[idx] = v * sigm(v); }
        __syncthreads();
        float* modv = (float*)(ws + WS_MODV);
        for (int u = blockIdx.x; u < 192; u += G) {
            const int l = u / 96, n0 = (u % 96) * 128, cg = tid & 31, kq = tid >> 5;
            f32x4 ac[5];
#pragma unroll
            for (int r = 0; r < 5; ++r) ac[r] = (f32x4){0.f, 0.f, 0.f, 0.f};
            const float* wp = a.in[I_ADAW] + ((size_t)l * 2048 + kq * 128) * NMOD + n0 + cg * 4;
#pragma unroll 8
            for (int kk = 0; kk < 128; ++kk) {
                const f32x4 w = *(const f32x4*)(wp + (size_t)kk * NMOD);
#pragma unroll
                for (int r = 0; r < 5; ++r) { const float s = sc[r * 2048 + kq * 128 + kk]; ac[r] += s * w; }
            }
#pragma unroll
            for (int r = 0; r < 5; ++r) *(LAS f32x4*)(red + (kq * 5 + r) * 128 + cg * 4) = ac[r];
            __syncthreads();
            for (int idx = tid; idx < 640; idx += 512) { const int r = idx >> 7, n = idx & 127; float s = a.in[I_ADAB][l * NMOD + n0 + n];
                for (int q = 0; q < 16; ++q) s += red[(q * 5 + r) * 128 + n];
                modv[((size_t)l * 5 + r) * NMOD + n0 + n] = s; }
            __syncthreads();
        }
    }
    if ((int)blockIdx.x == G - 1) {
        float* lb = (float*)(ws + WS_LB); float* cs = (float*)(ws + WS_ROPE);
        for (int idx = tid; idx < 4096; idx += 512) {
            const float l0 = a.in[I_HGLB][idx], l1 = a.in[I_HGLB][4096 + idx], l2 = a.in[I_HGLB][8192 + idx];
            const float mx = fmaxf(l0, fmaxf(l1, l2)); const float e0 = expf(l0 - mx), e1 = expf(l1 - mx), e2 = expf(l2 - mx);
            lb[idx] = e0 / (e0 + e1 + e2);
        }
        for (int idx = tid; idx < 1024; idx += 512) { const int pos = idx >> 4, i = idx & 15; const float fr = powf(10000.0f, -(float)i / 16.0f); const float ang = (float)pos * fr;
            cs[idx * 2] = cosf(ang); cs[idx * 2 + 1] = sinf(ang); }
    }
    __syncthreads();
}

DI void ph_modulate(const float* xl, const float* xc, const float* modl  , int jshift, int jscale, bf16_t* hout, int G) {
    const int tid = tid_(); const int lane = tid & 63, wv = __builtin_amdgcn_readfirstlane(tid >> 6);
    for (int row = blockIdx.x * 8 + wv; row < T; row += G * 8) {
        const float* xp = row < TL ? xl + (size_t)row * DM : xc + (size_t)(row - TL) * DM;
        const float* mp = modl + (size_t)(row < TL ? (row >> 12) : 4) * NMOD;
        f32x4 x[8]; float s = 0.f;
#pragma unroll
        for (int i = 0; i < 8; ++i) { x[i] = *(const f32x4*)(xp + (i * 64 + lane) * 4); s += (x[i][0] + x[i][1]) + (x[i][2] + x[i][3]); }
        const float mean = wave_sum(s) * (1.0f / DM); float q = 0.f;
#pragma unroll
        for (int i = 0; i < 8; ++i) { const f32x4 d = x[i] - mean; q += (d[0] * d[0] + d[1] * d[1]) + (d[2] * d[2] + d[3] * d[3]); }
        const float rstd = rsqrtf(wave_sum(q) * (1.0f / DM) + LN_EPS);
#pragma unroll
        for (int i = 0; i < 8; ++i) { const int d0 = (i * 64 + lane) * 4; const f32x4 sh = *(const f32x4*)(mp + jshift * DM + d0), sc = *(const f32x4*)(mp + jscale * DM + d0);
            const f32x4 hv = (x[i] - mean) * rstd * (1.0f + sc) + sh;
            *(unsigned*)((unsigned char*)hout + (size_t)row * DM + d0) = pk8(clamp8(hv[0] * F8_ASCALE), clamp8(hv[1] * F8_ASCALE), clamp8(hv[2] * F8_ASCALE), clamp8(hv[3] * F8_ASCALE)); }
    }
}

DI void ph_hg_combine(const Args& a, int G) {
    const bf16_t* of = (const bf16_t*)(a.ws + WS_OF); const bf16_t* ob = (const bf16_t*)(a.ws + WS_OB); const bf16_t* P = (const bf16_t*)(a.ws + WS_P);
    bf16_t* og = (bf16_t*)(a.ws + WS_OG); const float* gn = a.in[I_HGGN];
    const int tid = tid_(); const int lane = tid & 63, wv = __builtin_amdgcn_readfirstlane(tid >> 6);
    for (int row = blockIdx.x * 8 + wv; row < T; row += G * 8) {
        float o[32]; float ss = 0.f;
#pragma unroll
        for (int q = 0; q < 4; ++q) { const u32x4 f = *(const u32x4*)(of + (size_t)row * DM + lane * 32 + q * 8), b = *(const u32x4*)(ob + (size_t)row * DM + lane * 32 + q * 8);
#pragma unroll
            for (int j = 0; j < 4; ++j) { o[q * 8 + 2 * j] = bf_lo(f[j]) + bf_lo(b[j]); o[q * 8 + 2 * j + 1] = bf_hi(f[j]) + bf_hi(b[j]); } }
#pragma unroll
        for (int j = 0; j < 32; ++j) ss += o[j] * o[j];
        ss += __shfl_xor(ss, 1); ss += __shfl_xor(ss, 2);
        const float r = rsqrtf(ss * (1.0f / 128.0f) + RMS_EPS);
#pragma unroll
        for (int q = 0; q < 4; ++q) { const u32x4 g = *(const u32x4*)(P + (size_t)row * HGN + 8192 + lane * 32 + q * 8);
            const f32x4 w0 = *(const f32x4*)(gn + lane * 32 + q * 8), w1 = *(const f32x4*)(gn + lane * 32 + q * 8 + 4);
            float t[8];
#pragma unroll
            for (int j = 0; j < 4; ++j) { t[2 * j] = o[q * 8 + 2 * j] * r * (j < 2 ? w0[2 * j] : w1[2 * j - 4]) * bf_lo(g[j]); t[2 * j + 1] = o[q * 8 + 2 * j + 1] * r * (j < 2 ? w0[2 * j + 1] : w1[2 * j - 3]) * bf_hi(g[j]); }
#pragma unroll
            for (int j = 0; j < 8; ++j) t[j] = clamp8(t[j] * F8_OGSCALE);
            u32x2 w; w.x = pk8(t[0], t[1], t[2], t[3]); w.y = pk8(t[4], t[5], t[6], t[7]);
            *(u32x2*)((unsigned char*)og + (size_t)row * DM + lane * 32 + q * 8) = w; }
    }
}

DI void ph_post_router(const Args& a, int layer, const float* xl, const float* xc, const bf16_t* y, int nrows, LAS unsigned char* lds, int G) {
    unsigned char* ws = a.ws;
    const int tid = tid_(), lane = tid & 63, wv = __builtin_amdgcn_readfirstlane(tid >> 6);
    const float* modl = (const float*)(ws + WS_MODV) + (size_t)layer * 5 * NMOD;
    const float* lng = a.in[I_LNG] + (size_t)(layer * 2 + 0) * DM; const float* lnb = a.in[I_LNB] + (size_t)(layer * 2 + 0) * DM;
    const float* rw = a.in[I_RW] + (size_t)layer * DM * NE; const float* rb = a.in[I_RB] + layer * NE;
    float* x1 = (float*)(ws + WS_X1); bf16_t* h2 = (bf16_t*)(ws + WS_H2);
    unsigned* cnt = (unsigned*)(ws + (layer ? CTL_CNT1 : CTL_CNT0));
    int* ltok = (int*)(ws + WS_LTOK); float* lgate = (float*)(ws + WS_LGATE); unsigned* tokes = (unsigned*)(ws + WS_TOKES);
    LAS float* hs = (LAS float*)lds;
    LAS int* asg_e = (LAS int*)(lds + TAB_OFF); LAS float* asg_g = (LAS float*)(lds + TAB_OFF + 2048); LAS int* asg_s = (LAS int*)(lds + TAB_OFF + 4096);
    LAS int* lc = (LAS int*)(lds + TAB_OFF + 6144); LAS int* lbase = (LAS int*)(lds + TAB_OFF + 6400);
    const int rpb = nrows / G, row0 = blockIdx.x * rpb;
    if (tid < 32) lc[tid] = 0;
    __syncthreads();
    for (int g0 = 0; g0 < rpb; g0 += 16) {
#pragma unroll 1
        for (int rr = 0; rr < 2; ++rr) {
            const int lr = wv * 2 + rr, ri = g0 + lr;
            if (ri < rpb) {
                const int row = row0 + ri;
                const float* xp = row < TL ? xl + (size_t)row * DM : xc + (size_t)(row - TL) * DM;
                const float* mp = modl + (size_t)(row < TL ? (row >> 12) : 4) * NMOD;
                f32x4 z[8]; float s = 0.f;
#pragma unroll
                for (int i = 0; i < 8; ++i) { const int d0 = (i * 64 + lane) * 4; const f32x4 xv = *(const f32x4*)(xp + d0); const u32x2 yv = *(const u32x2*)(y + (size_t)row * DM + d0);
                    const f32x4 gt = *(const f32x4*)(mp + 2 * DM + d0); const f32x4 yf = {bf_lo(yv.x), bf_hi(yv.x), bf_lo(yv.y), bf_hi(yv.y)};
                    z[i] = DN_ALPHA * xv + gt * yf; s += (z[i][0] + z[i][1]) + (z[i][2] + z[i][3]); }
                float mean = wave_sum(s) * (1.0f / DM), q = 0.f;
#pragma unroll
                for (int i = 0; i < 8; ++i) { const f32x4 d = z[i] - mean; q += (d[0] * d[0] + d[1] * d[1]) + (d[2] * d[2] + d[3] * d[3]); }
                float rstd = rsqrtf(wave_sum(q) * (1.0f / DM) + LN_EPS);
                s = 0.f;
#pragma unroll
                for (int i = 0; i < 8; ++i) { const int d0 = (i * 64 + lane) * 4; const f32x4 gg = *(const f32x4*)(lng + d0), bb = *(const f32x4*)(lnb + d0);
                    z[i] = (z[i] - mean) * rstd * gg + bb; *(f32x4*)(x1 + (size_t)row * DM + d0) = z[i]; s += (z[i][0] + z[i][1]) + (z[i][2] + z[i][3]); }
                mean = wave_sum(s) * (1.0f / DM); q = 0.f;
#pragma unroll
                for (int i = 0; i < 8; ++i) { const f32x4 d = z[i] - mean; q += (d[0] * d[0] + d[1] * d[1]) + (d[2] * d[2] + d[3] * d[3]); }
                rstd = rsqrtf(wave_sum(q) * (1.0f / DM) + LN_EPS);
#pragma unroll
                for (int i = 0; i < 8; ++i) { const int d0 = (i * 64 + lane) * 4; const f32x4 sh = *(const f32x4*)(mp + 3 * DM + d0), sc = *(const f32x4*)(mp + 4 * DM + d0);
                    const f32x4 hv = (z[i] - mean) * rstd * (1.0f + sc) + sh; u32x2 w; w.x = pk(hv[0], hv[1]); w.y = pk(hv[2], hv[3]);
                    if (true) *(unsigned*)((unsigned char*)h2 + (size_t)row * DM + d0) = pk8(clamp8(hv[0] * F8_ASCALE), clamp8(hv[1] * F8_ASCALE), clamp8(hv[2] * F8_ASCALE), clamp8(hv[3] * F8_ASCALE));
                    else *(u32x2*)(h2 + (size_t)row * DM + d0) = w;
                    *(LAS f32x4*)(hs + lr * DM + d0) = hv; }
            }
        }
        __syncthreads();
        {
            LAS float* red = (LAS float*)(lds + TAB_OFF + 8192);
            {
                const int e = tid & 31, rg = (tid >> 5) & 3, dq = tid >> 7;
                float ac[4] = {0.f, 0.f, 0.f, 0.f};
                const LAS float* hp = hs + (4 * rg) * DM + dq * 512; const float* wp = rw + (size_t)(dq * 512) * NE + e;
#pragma unroll 2
                for (int d = 0; d < 512; d += 4) {
                    const float w0 = wp[(d + 0) * NE], w1 = wp[(d + 1) * NE], w2 = wp[(d + 2) * NE], w3 = wp[(d + 3) * NE];
#pragma unroll
                    for (int r = 0; r < 4; ++r) { const f32x4 hv = *(const LAS f32x4*)(hp + r * DM + d); ac[r] += (hv[0] * w0 + hv[1] * w1) + (hv[2] * w2 + hv[3] * w3); }
                }
#pragma unroll
                for (int r = 0; r < 4; ++r) red[(dq * 16 + 4 * rg + r) * 32 + e] = ac[r];
            }
            __syncthreads();
            const int lr = tid >> 5, e = tid & 31, ri = g0 + lr;
            float val = (red[lr * 32 + e] + red[(16 + lr) * 32 + e]) + (red[(32 + lr) * 32 + e] + red[(48 + lr) * 32 + e]) + rb[e];
            float tv[4]; int te[4];
#pragma unroll
            for (int k = 0; k < 4; ++k) {
                float m = val;
#pragma unroll
                for (int o = 16; o >= 1; o >>= 1) m = fmaxf(m, __shfl_xor(m, o));
                int idx = (val == m) ? e : 99;
#pragma unroll
                for (int o = 16; o >= 1; o >>= 1) idx = min(idx, __shfl_xor(idx, o));
                tv[k] = m; te[k] = idx; if (e == idx) val = -3.0e38f;
            }
            if (e == 0 && ri < rpb) {
                const float e1 = __expf(tv[1] - tv[0]), e2 = __expf(tv[2] - tv[0]), e3 = __expf(tv[3] - tv[0]); const float inv = 1.0f / (1.0f + e1 + e2 + e3);
                const float gk[4] = {inv, e1 * inv, e2 * inv, e3 * inv};
#pragma unroll
                for (int k = 0; k < 4; ++k) { const int ai = ri * 4 + k; asg_e[ai] = te[k]; asg_g[ai] = gk[k]; asg_s[ai] = atomicAdd((int*)(lc + te[k]), 1); }
            }
        }
        __syncthreads();
    }
    if (tid < 32) lbase[tid] = (int)__hip_atomic_fetch_add(cnt + tid * 64, (unsigned)lc[tid], __ATOMIC_RELAXED, __HIP_MEMORY_SCOPE_AGENT);
    __syncthreads();
    for (int ai = tid; ai < rpb * 4; ai += 512) {
        const int row = row0 + (ai >> 2), e = asg_e[ai], slot = lbase[e] + asg_s[ai];
        ltok[(size_t)e * TCAP + slot] = row; lgate[(size_t)e * TCAP + slot] = asg_g[ai]; tokes[(size_t)row * 4 + (ai & 3)] = ((unsigned)slot << 5) | (unsigned)e;
    }
    __syncthreads();
}

DI void moe_setup(const Args& a, int layer, LAS unsigned char* lds) {
    LAS int* tb = (LAS int*)(lds + LCTL_OFF + 64); LAS int* cn = (LAS int*)(lds + LCTL_OFF + 256);
    unsigned* cnt = (unsigned*)(a.ws + (layer ? CTL_CNT1 : CTL_CNT0));
    __syncthreads();
    if (threadIdx.x < 32) cn[threadIdx.x] = (int)__hip_atomic_load(cnt + threadIdx.x * 64, __ATOMIC_RELAXED, __HIP_MEMORY_SCOPE_AGENT);
    __syncthreads();
    if (threadIdx.x == 0) { int s = 0; for (int e = 0; e < 32; ++e) { tb[e] = s; s += (cn[e] + 255) >> 8; } tb[32] = s; }
    if (threadIdx.x == 64) { LAS int* th = (LAS int*)(lds + LCTL_OFF + 640); int s = 0; for (int e = 0; e < 32; ++e) { th[e] = s; s += (cn[e] + 127) >> 7; } th[32] = s; }
    __syncthreads();
}

DI void ph_post_ffn(const Args& a, int layer, int nrows, float* outp, bool next_mod, LAS unsigned char* lds, int G) {
    unsigned char* ws = a.ws;
    moe_setup(a, layer, lds);
    const LAS int* tb = (const LAS int*)(lds + LCTL_OFF + 64);
    const int tid = tid_(); const int lane = tid & 63, wv = __builtin_amdgcn_readfirstlane(tid >> 6);
    const float* modl = (const float*)(ws + WS_MODV) + (size_t)layer * 5 * NMOD;
    const float* modn = (const float*)(ws + WS_MODV) + (size_t)(layer + 1) * 5 * NMOD;
    const float* lng = a.in[I_LNG] + (size_t)(layer * 2 + 1) * DM; const float* lnb = a.in[I_LNB] + (size_t)(layer * 2 + 1) * DM;
    const float* x1 = (const float*)(ws + WS_X1); const bf16_t* y2 = (const bf16_t*)(ws + WS_Y2); const unsigned* tokes = (const unsigned*)(ws + WS_TOKES);
    bf16_t* hn = (bf16_t*)(ws + WS_H);
    for (int row = blockIdx.x * 8 + wv; row < nrows; row += G * 8) {
        const int rsel = row < TL ? (row >> 12) : 4;
        const float* mp = modl + (size_t)rsel * NMOD;
        size_t pr[4];
#pragma unroll
        for (int k = 0; k < 4; ++k) { const unsigned es = tokes[(size_t)row * 4 + k]; const int e = es & 31, slot = es >> 5; pr[k] = ((size_t)tb[e] * 256 + slot) * DM; }
        f32x4 z[8]; float s = 0.f;
#pragma unroll
        for (int i = 0; i < 8; ++i) { const int d0 = (i * 64 + lane) * 4; f32x4 ys = {0.f, 0.f, 0.f, 0.f};
#pragma unroll
            for (int k = 0; k < 4; ++k) { const u32x2 yv = *(const u32x2*)(y2 + pr[k] + d0); ys += (f32x4){bf_lo(yv.x), bf_hi(yv.x), bf_lo(yv.y), bf_hi(yv.y)}; }
            const f32x4 xv = *(const f32x4*)(x1 + (size_t)row * DM + d0), gt = *(const f32x4*)(mp + 5 * DM + d0);
            z[i] = DN_ALPHA * xv + gt * ys; s += (z[i][0] + z[i][1]) + (z[i][2] + z[i][3]); }
        float mean = wave_sum(s) * (1.0f / DM), q = 0.f;
#pragma unroll
        for (int i = 0; i < 8; ++i) { const f32x4 d = z[i] - mean; q += (d[0] * d[0] + d[1] * d[1]) + (d[2] * d[2] + d[3] * d[3]); }
        float rstd = rsqrtf(wave_sum(q) * (1.0f / DM) + LN_EPS);
        s = 0.f;
#pragma unroll
        for (int i = 0; i < 8; ++i) { const int d0 = (i * 64 + lane) * 4; const f32x4 gg = *(const f32x4*)(lng + d0), bb = *(const f32x4*)(lnb + d0);
            z[i] = (z[i] - mean) * rstd * gg + bb; *(f32x4*)(outp + (size_t)row * DM + d0) = z[i]; s += (z[i][0] + z[i][1]) + (z[i][2] + z[i][3]); }
        if (next_mod) {
            const float* mq = modn + (size_t)rsel * NMOD;
            mean = wave_sum(s) * (1.0f / DM); q = 0.f;
#pragma unroll
            for (int i = 0; i < 8; ++i) { const f32x4 d = z[i] - mean; q += (d[0] * d[0] + d[1] * d[1]) + (d[2] * d[2] + d[3] * d[3]); }
            rstd = rsqrtf(wave_sum(q) * (1.0f / DM) + LN_EPS);
#pragma unroll
            for (int i = 0; i < 8; ++i) { const int d0 = (i * 64 + lane) * 4; const f32x4 sh = *(const f32x4*)(mq + 0 * DM + d0), sc = *(const f32x4*)(mq + 1 * DM + d0);
                const f32x4 hv = (z[i] - mean) * rstd * (1.0f + sc) + sh; u32x2 w; w.x = pk(hv[0], hv[1]); w.y = pk(hv[2], hv[3]);
                *(u32x2*)(hn + (size_t)row * DM + d0) = w; }
        }
    }
}

DI void ph_mla_local(const Args& a, int G) {
    unsigned char* ws = a.ws;
    const float* pm = (const float*)(ws + WS_PM); bf16_t* cqn = (bf16_t*)(ws + WS_CQN); bf16_t* ckvn = (bf16_t*)(ws + WS_CKVN); bf16_t* kp = (bf16_t*)(ws + WS_KP);
    const float* cs = (const float*)(ws + WS_ROPE); const float* qw = a.in[I_MQN]; const float* kw = a.in[I_MKVN];
    const int tid = tid_(); const int lane = tid & 63, wv = __builtin_amdgcn_readfirstlane(tid >> 6);
    for (int row = blockIdx.x * 8 + wv; row < T; row += G * 8) {
        const float* pp = pm + (size_t)row * 1088;
        {   const f32x4 c0 = *(const f32x4*)(pp + 512 + lane * 8), c1 = *(const f32x4*)(pp + 512 + lane * 8 + 4);
            float ss = (c0[0] * c0[0] + c0[1] * c0[1]) + (c0[2] * c0[2] + c0[3] * c0[3]) + (c1[0] * c1[0] + c1[1] * c1[1]) + (c1[2] * c1[2] + c1[3] * c1[3]);
            const float r = rsqrtf(wave_sum(ss) * (1.0f / 512.0f) + RMS_EPS);
            const f32x4 w0 = *(const f32x4*)(kw + lane * 8), w1 = *(const f32x4*)(kw + lane * 8 + 4);
            u32x4 w; w.x = pk(c0[0] * r * w0[0], c0[1] * r * w0[1]); w.y = pk(c0[2] * r * w0[2], c0[3] * r * w0[3]); w.z = pk(c1[0] * r * w1[0], c1[1] * r * w1[1]); w.w = pk(c1[2] * r * w1[2], c1[3] * r * w1[3]);
            *(u32x4*)(ckvn + (size_t)row * 512 + lane * 8) = w; }
        if (row < TL) {
            const f32x4 c0 = *(const f32x4*)(pp + lane * 8), c1 = *(const f32x4*)(pp + lane * 8 + 4);
            float ss = (c0[0] * c0[0] + c0[1] * c0[1]) + (c0[2] * c0[2] + c0[3] * c0[3]) + (c1[0] * c1[0] + c1[1] * c1[1]) + (c1[2] * c1[2] + c1[3] * c1[3]);
            const float r = rsqrtf(wave_sum(ss) * (1.0f / 512.0f) + RMS_EPS);
            const f32x4 w0 = *(const f32x4*)(qw + lane * 8), w1 = *(const f32x4*)(qw + lane * 8 + 4);
            u32x4 w; w.x = pk(c0[0] * r * w0[0], c0[1] * r * w0[1]); w.y = pk(c0[2] * r * w0[2], c0[3] * r * w0[3]); w.z = pk(c1[0] * r * w1[0], c1[1] * r * w1[1]); w.w = pk(c1[2] * r * w1[2], c1[3] * r * w1[3]);
            *(u32x4*)(cqn + (size_t)row * 512 + lane * 8) = w;
        }
        if (lane < 32) {
            const int i = lane & 15, half = lane >> 4;
            const float xa = pp[1024 + 32 * half + i], xb = pp[1024 + 32 * half + 16 + i];
            float oa = xa, ob = xb;
            if (row < TL) { const int s = row & (SEQ - 1); const int pos = half ? (s & 63) : (s >> 6); const float c = cs[(pos * 16 + i) * 2], sn = cs[(pos * 16 + i) * 2 + 1];
                oa = xa * c - xb * sn; ob = xa * sn + xb * c; }
            const unsigned wa = pk(oa, 0.f), wb = pk(ob, 0.f);
            kp[(size_t)row * 64 + 32 * half + i] = (bf16_t)(wa & 0xffffu); kp[(size_t)row * 64 + 32 * half + 16 + i] = (bf16_t)(wb & 0xffffu);
        }
    }
}

namespace hg {
constexpr int QH_OFF = 0, QT_OFF = 8704, KT_OFF = 17408, KHT_OFF = 26112, VT_OFF = 36352, EB_OFF = 46592, BUFB = 47104, NCH = LSEQ / 32, NCHAIN = 128;
DI int crow(int r, int hi) { return (r & 3) + 8 * (r >> 2) + 4 * hi; }
DI int rowof(int b, int dir, int pos) {
    if (pos < LC) return TL + b * LC + (dir ? (LC - 1 - pos) : pos);
    const int s = pos - LC; return b * SEQ + (dir ? (SEQ - 1 - s) : s);
}
DI bf16x8 pack8(const f32x16& x, int s) { u32x4 p; p.x = pk(x[8 * s], x[8 * s + 1]); p.y = pk(x[8 * s + 2], x[8 * s + 3]); p.z = pk(x[8 * s + 4], x[8 * s + 5]); p.w = pk(x[8 * s + 6], x[8 * s + 7]); return __builtin_bit_cast(bf16x8, p); }
#define HG_MFMA(a, b, c) __builtin_amdgcn_mfma_f32_32x32x16_bf16((a), (b), (c), 0, 0, 0)

DI void scan(const Args& a, LAS unsigned char* lds, int nblk) {
    const bf16_t* P = (const bf16_t*)(a.ws + WS_P);
    const int tid = tid_(), lane = tid & 63, wid = __builtin_amdgcn_readfirstlane(tid >> 6), r32 = lane & 31, hi = lane >> 5;
    const int tau = tid & 31, pc = tid >> 5;
    for (int ch = blockIdx.x; ch < NCHAIN; ch += nblk) {
        const int b = ch >> 5, h = (ch >> 1) & 15, dir = ch & 1;
        bf16_t* O = (bf16_t*)(a.ws + (dir ? WS_OB : WS_OF));
        f32x16 S[4];
#pragma unroll
        for (int i = 0; i < 4; ++i)
#pragma unroll
            for (int r = 0; r < 16; ++r) S[i][r] = 0.f;
        u32x4 qv, lv, vv = {0u, 0u, 0u, 0u};
#define HG_LOAD(cc) do { const size_t rb = (size_t)rowof(b, dir, (cc) * 32 + tau) * HGN; \
            qv = *(const u32x4*)(P + rb + h * 128 + pc * 8); lv = *(const u32x4*)(P + rb + 2048 * (1 + dir) + h * 128 + pc * 8); \
            vv = *(const u32x4*)(P + rb + 6144 + h * 128 + pc * 8); } while (0)
        HG_LOAD(0);
        for (int c = 0; c < NCH; ++c) {
            LAS unsigned char* buf = lds + (c & 1) * BUFB;
            {
                float lf[8], qf[8], bc[8];
#pragma unroll
                for (int j = 0; j < 4; ++j) { lf[2 * j] = bf_lo(lv[j]); lf[2 * j + 1] = bf_hi(lv[j]); qf[2 * j] = bf_lo(qv[j]); qf[2 * j + 1] = bf_hi(qv[j]); }
#pragma unroll
                for (int j = 0; j < 8; ++j) { float v = lf[j];
#pragma unroll
                    for (int d = 1; d < 32; d <<= 1) { const float t = __shfl_up(v, d, 32); if (tau >= d) v += t; }
                    bc[j] = v; }
                float qh[8], qt[8], kt[8], kh[8], eb[8];
#pragma unroll
                for (int j = 0; j < 8; ++j) { const float bm = __shfl(bc[j], 15, 32), bl = __shfl(bc[j], 31, 32); const float kk = 1.0f - __expf(lf[j]);
                    qh[j] = qf[j] * __expf(bc[j]); qt[j] = qf[j] * __expf(bc[j] - bm); kt[j] = kk * __expf(bm - bc[j]); kh[j] = kk * __expf(bl - bc[j]); eb[j] = __expf(bl); }
                {   const int i = pc >> 2, hf = (pc & 3) >> 1, sec = pc & 1; const int p1 = 32 * i + 16 * hf + 4 * sec, p2 = p1 + 8;
                    u32x2 w1, w2; w1.x = pk(qh[0], qh[1]); w1.y = pk(qh[2], qh[3]); w2.x = pk(qh[4], qh[5]); w2.y = pk(qh[6], qh[7]);
                    *(LAS u32x2*)(buf + QH_OFF + tau * 272 + p1 * 2) = w1; *(LAS u32x2*)(buf + QH_OFF + tau * 272 + p2 * 2) = w2; }
                {   u32x4 w; w.x = pk(qt[0], qt[1]); w.y = pk(qt[2], qt[3]); w.z = pk(qt[4], qt[5]); w.w = pk(qt[6], qt[7]); *(LAS u32x4*)(buf + QT_OFF + tau * 272 + pc * 16) = w; }
                {   u32x4 w; w.x = pk(kt[0], kt[1]); w.y = pk(kt[2], kt[3]); w.z = pk(kt[4], kt[5]); w.w = pk(kt[6], kt[7]); *(LAS u32x4*)(buf + KT_OFF + tau * 272 + pc * 16) = w; }
#pragma unroll
                for (int j = 0; j < 8; ++j) { const unsigned w = pk(kh[j], 0.f); *(LAS bf16_t*)(buf + KHT_OFF + (8 * pc + j) * 80 + tau * 2) = (bf16_t)(w & 0xffffu); }
                {
#pragma unroll
                    for (int j = 0; j < 4; ++j) { *(LAS bf16_t*)(buf + VT_OFF + (8 * pc + 2 * j) * 80 + tau * 2) = (bf16_t)(vv[j] & 0xffffu); *(LAS bf16_t*)(buf + VT_OFF + (8 * pc + 2 * j + 1) * 80 + tau * 2) = (bf16_t)(vv[j] >> 16); }
                }
                if (tau == 31) {
#pragma unroll
                    for (int j = 0; j < 8; ++j) *(LAS float*)(buf + EB_OFF + (8 * pc + j) * 4) = eb[j];
                }
            }
            if (c + 1 < NCH) HG_LOAD(c + 1);
            __syncthreads();
            if (wid < 4) {
                const int jv = wid;
                f32x16 at;
#pragma unroll
                for (int r = 0; r < 16; ++r) at[r] = 0.f;
#pragma unroll
                for (int kk = 0; kk < 8; ++kk) { const bf16x8 ka = *(const LAS bf16x8*)(buf + KT_OFF + r32 * 272 + (16 * kk + 8 * hi) * 2), qb = *(const LAS bf16x8*)(buf + QT_OFF + r32 * 272 + (16 * kk + 8 * hi) * 2);
                    at = HG_MFMA(ka, qb, at); }
#pragma unroll
                for (int r = 0; r < 16; ++r) at[r] = (crow(r, hi) <= r32) ? at[r] : 0.f;
                const bf16x8 ab0 = pack8(at, 0), ab1 = pack8(at, 1);
                f32x16 ot;
#pragma unroll
                for (int r = 0; r < 16; ++r) ot[r] = 0.f;
                {   const LAS unsigned char* vp = buf + VT_OFF + (32 * jv + r32) * 80;
                    const s16x4 a0 = *(const LAS s16x4*)(vp + (4 * hi) * 2), a1 = *(const LAS s16x4*)(vp + (8 + 4 * hi) * 2), a2 = *(const LAS s16x4*)(vp + (16 + 4 * hi) * 2), a3 = *(const LAS s16x4*)(vp + (24 + 4 * hi) * 2);
                    const bf16x8 va0 = {a0[0], a0[1], a0[2], a0[3], a1[0], a1[1], a1[2], a1[3]}, va1 = {a2[0], a2[1], a2[2], a2[3], a3[0], a3[1], a3[2], a3[3]};
                    ot = HG_MFMA(va0, ab0, ot); ot = HG_MFMA(va1, ab1, ot); }
#pragma unroll
                for (int i = 0; i < 4; ++i) { const bf16x8 sa0 = pack8(S[i], 0), sa1 = pack8(S[i], 1);
                    const bf16x8 q0 = *(const LAS bf16x8*)(buf + QH_OFF + r32 * 272 + (32 * i + 8 * hi) * 2), q1 = *(const LAS bf16x8*)(buf + QH_OFF + r32 * 272 + (32 * i + 16 + 8 * hi) * 2);
                    ot = HG_MFMA(sa0, q0, ot); ot = HG_MFMA(sa1, q1, ot); }
                {   bf16_t* op = O + (size_t)rowof(b, dir, c * 32 + r32) * DM + h * 128 + 32 * jv + 4 * hi;
#pragma unroll
                    for (int g = 0; g < 4; ++g) { u32x2 w; w.x = pk(ot[4 * g], ot[4 * g + 1]); w.y = pk(ot[4 * g + 2], ot[4 * g + 3]); *(u32x2*)(op + 8 * g) = w; } }
#pragma unroll
                for (int i = 0; i < 4; ++i) {
#pragma unroll
                    for (int g = 0; g < 4; ++g) { const f32x4 e = *(const LAS f32x4*)(buf + EB_OFF + (32 * i + 8 * g + 4 * hi) * 4);
                        S[i][4 * g] *= e[0]; S[i][4 * g + 1] *= e[1]; S[i][4 * g + 2] *= e[2]; S[i][4 * g + 3] *= e[3]; }
#pragma unroll
                    for (int st = 0; st < 2; ++st) { const bf16x8 ka = *(const LAS bf16x8*)(buf + KHT_OFF + (32 * i + r32) * 80 + (16 * st + 8 * hi) * 2), vb = *(const LAS bf16x8*)(buf + VT_OFF + (32 * jv + r32) * 80 + (16 * st + 8 * hi) * 2);
                        S[i] = HG_MFMA(ka, vb, S[i]); }
                }
            }
        }
        __syncthreads();
#undef HG_LOAD
    }
}
}

namespace att {
constexpr int NW = 8, KVBLK = 64, NT = LSEQ / KVBLK;
constexpr float SCALE = 0.07216878364870322f;
constexpr float THR = 8.f;
constexpr int SHM_V = 16384, SHM_K = 64 * 384, V_OFF = 0, K_OFF = 2 * SHM_V, W_OFF = K_OFF + 2 * SHM_K;
#define KSWZ(row, colB) ((row) * 384 + ((colB) ^ ((((row) >> 1) & 7) << 4)))
#define SBAR() __builtin_amdgcn_sched_barrier(0)
DI int crow(int r, int hi) { return (r & 3) + 8 * (r >> 2) + 4 * hi; }
DI unsigned cvtpk(float lo, float hi) { return pk(lo, hi); }
DI int krow(int b, int k) { return k < LC ? TL + b * LC + k : b * SEQ + (k - LC); }

DI void partialSM(f32x16& p0, f32x16& p1, float& m_reg, float& mn, float& alpha) {
  constexpr float C = SCALE * 1.4426950408889634f;
  float pmax = p0[0];
#pragma unroll
  for (int r = 1; r < 16; ++r) pmax = fmaxf(pmax, p0[r]);
#pragma unroll
  for (int r = 0; r < 16; ++r) pmax = fmaxf(pmax, p1[r]);
  { auto rr = __builtin_amdgcn_permlane32_swap(__float_as_uint(pmax), __float_as_uint(pmax), false, false);
    pmax = fmaxf(__uint_as_float(rr[0]), __uint_as_float(rr[1])); }
  if (__builtin_expect(__all(pmax - m_reg <= THR / SCALE), 1)) { mn = m_reg; alpha = 1.f; }
  else { mn = fmaxf(m_reg, pmax); alpha = __builtin_amdgcn_exp2f((m_reg - mn) * C); m_reg = mn; }
  const float mnC = -mn * C;
#pragma unroll
  for (int r = 0; r < 16; ++r) p0[r] = fmaf(p0[r], C, mnC);
#pragma unroll
  for (int r = 0; r < 16; ++r) p1[r] = fmaf(p1[r], C, mnC);
#pragma unroll
  for (int r = 0; r < 16; ++r) p0[r] = __builtin_amdgcn_exp2f(p0[r]);
}
DI void finishSM(f32x16& p0, f32x16& p1, float alpha, float& l_reg, bf16x8& pa0, bf16x8& pa1, bf16x8& pa2, bf16x8& pa3) {
#pragma unroll
  for (int r = 0; r < 16; ++r) p1[r] = __builtin_amdgcn_exp2f(p1[r]);
  float ps = 0;
#pragma unroll
  for (int r = 0; r < 16; ++r) ps += p0[r];
#pragma unroll
  for (int r = 0; r < 16; ++r) ps += p1[r];
  { auto rr = __builtin_amdgcn_permlane32_swap(__float_as_uint(ps), __float_as_uint(ps), false, false);
    ps = __uint_as_float(rr[0]) + __uint_as_float(rr[1]); }
  l_reg = l_reg * alpha + ps;
#define PK4(P, BASE, OUT) do { unsigned a0 = cvtpk(P[BASE + 0], P[BASE + 1]), a1 = cvtpk(P[BASE + 2], P[BASE + 3]);   \
    unsigned b0 = cvtpk(P[BASE + 4], P[BASE + 5]), b1 = cvtpk(P[BASE + 6], P[BASE + 7]);                              \
    auto r0 = __builtin_amdgcn_permlane32_swap(a0, b0, false, false); auto r1 = __builtin_amdgcn_permlane32_swap(a1, b1, false, false); \
    u32x4 w = {r0[0], r1[0], r0[1], r1[1]}; OUT = __builtin_bit_cast(bf16x8, w); } while (0)
  PK4(p0, 0, pa0); PK4(p0, 8, pa1); PK4(p1, 0, pa2); PK4(p1, 8, pa3);
#undef PK4
}
DI void qkt(f32x16& p0, f32x16& p1, const LAS unsigned char* Ks, const bf16x8 (&qr)[12], int r32, int hi) {
#pragma unroll
  for (int r = 0; r < 16; ++r) { p0[r] = 0.f; p1[r] = 0.f; }
#pragma unroll
  for (int d0 = 0; d0 < 12; ++d0) { const int cb = (d0 * 16 + hi * 8) * 2;
    const bf16x8 b0 = *(const LAS bf16x8*)(Ks + KSWZ(r32, cb));
    const bf16x8 b1 = *(const LAS bf16x8*)(Ks + KSWZ(32 + r32, cb));
    p0 = __builtin_amdgcn_mfma_f32_32x32x16_bf16(b0, qr[d0], p0, 0, 0, 0);
    p1 = __builtin_amdgcn_mfma_f32_32x32x16_bf16(b1, qr[d0], p1, 0, 0, 0); }
}
DI int v_st(int k, int c) { const int kk = (k & ~0xC) | ((k & 4) << 1) | ((k & 8) >> 1); return ((kk >> 3) * 4 + (c >> 5)) * 512 + ((kk & 7) * 32 + (c & 31)) * 2; }
DI int v_rd_base(int lane) { return ((lane & 3) << 3) | (((lane >> 2) & 3) << 6) | (((lane >> 4) & 1) << 5) | (((lane >> 5) & 1) << 8); }
constexpr int v_rd_off(int d0, int ks, int half) { return d0 * 512 + ks * 4096 + half * 2048; }
template <int OFF> DI s16x4 tr_read(int vb) { s16x4 r; asm volatile("ds_read_b64_tr_b16 %0, %1 offset:%2" : "=&v"(r) : "v"(vb), "i"(OFF) : "memory"); return r; }
template <int D0> DI void pv_one(f32x16& od, int vb, bf16x8 pa0, bf16x8 pa1, bf16x8 pa2, bf16x8 pa3) {
  const s16x4 l0 = tr_read<v_rd_off(D0, 0, 0)>(vb), h0 = tr_read<v_rd_off(D0, 0, 1)>(vb), l1 = tr_read<v_rd_off(D0, 1, 0)>(vb), h1 = tr_read<v_rd_off(D0, 1, 1)>(vb);
  const s16x4 l2 = tr_read<v_rd_off(D0, 2, 0)>(vb), h2 = tr_read<v_rd_off(D0, 2, 1)>(vb), l3 = tr_read<v_rd_off(D0, 3, 0)>(vb), h3 = tr_read<v_rd_off(D0, 3, 1)>(vb);
  asm volatile("s_waitcnt lgkmcnt(0)" ::: "memory"); SBAR();
#define PKV(L, H) (bf16x8){L[0], L[1], L[2], L[3], H[0], H[1], H[2], H[3]}
  od = __builtin_amdgcn_mfma_f32_32x32x16_bf16(pa0, PKV(l0, h0), od, 0, 0, 0);
  od = __builtin_amdgcn_mfma_f32_32x32x16_bf16(pa1, PKV(l1, h1), od, 0, 0, 0);
  od = __builtin_amdgcn_mfma_f32_32x32x16_bf16(pa2, PKV(l2, h2), od, 0, 0, 0);
  od = __builtin_amdgcn_mfma_f32_32x32x16_bf16(pa3, PKV(l3, h3), od, 0, 0, 0);
#undef PKV
}
DI void pv_d0(f32x16 (&o)[4], int vb, bf16x8 pa0, bf16x8 pa1, bf16x8 pa2, bf16x8 pa3) {
  pv_one<0>(o[0], vb, pa0, pa1, pa2, pa3); pv_one<1>(o[1], vb, pa0, pa1, pa2, pa3); pv_one<2>(o[2], vb, pa0, pa1, pa2, pa3); pv_one<3>(o[3], vb, pa0, pa1, pa2, pa3);
}

DI void unit(const Args& a, LAS unsigned char* lds, int b, int h, int qb) {
  const bf16_t* Q = (const bf16_t*)(a.ws + WS_Q); const bf16_t* KV = (const bf16_t*)(a.ws + WS_KV); const bf16_t* KP = (const bf16_t*)(a.ws + WS_KP);
  const float* cs = (const float*)(a.ws + WS_ROPE); bf16_t* Ob = (bf16_t*)(a.ws + WS_OG);
  const int tid = tid_(), wid = tid >> 6, lane = tid & 63, r32 = lane & 31, hi = lane >> 5;
  LAS unsigned char* V_lds = lds + V_OFF; LAS unsigned char* K_lds = lds + K_OFF;
  LAS float* wsl = (LAS float*)(lds + W_OFF) + wid * 64; LAS float* li_l = wsl; LAS float* al_l = wsl + 32;
  float m_reg = -1e30f, l_reg = 0.f; f32x16 o[4]; bf16x8 qr[12];
#pragma unroll
  for (int d = 0; d < 4; ++d)
#pragma unroll
    for (int r = 0; r < 16; ++r) o[d][r] = 0.f;
  const int srow = qb * 256 + wid * 32 + r32;
  const bf16_t* Qw = Q + ((size_t)(b * SEQ + srow)) * 3072 + h * 192 + hi * 8;
#pragma unroll
  for (int d0 = 0; d0 < 8; ++d0) qr[d0] = *(const bf16x8*)(Qw + d0 * 16);
  {
      const u32x4 xa = *(const u32x4*)(Qw + 128), xb = *(const u32x4*)(Qw + 144), xc = *(const u32x4*)(Qw + 160), xd = *(const u32x4*)(Qw + 176);
      const float* cr = cs + ((srow >> 6) * 16 + hi * 8) * 2; const float* cc = cs + ((srow & 63) * 16 + hi * 8) * 2;
      float oa[8], ob[8], oc[8], od[8];
#pragma unroll
      for (int j = 0; j < 8; ++j) { const float x1 = (j & 1) ? bf_hi(xa[j >> 1]) : bf_lo(xa[j >> 1]), x2 = (j & 1) ? bf_hi(xb[j >> 1]) : bf_lo(xb[j >> 1]);
          const float c = cr[2 * j], s = cr[2 * j + 1]; oa[j] = x1 * c - x2 * s; ob[j] = x1 * s + x2 * c;
          const float y1 = (j & 1) ? bf_hi(xc[j >> 1]) : bf_lo(xc[j >> 1]), y2 = (j & 1) ? bf_hi(xd[j >> 1]) : bf_lo(xd[j >> 1]);
          const float c2 = cc[2 * j], s2 = cc[2 * j + 1]; oc[j] = y1 * c2 - y2 * s2; od[j] = y1 * s2 + y2 * c2; }
      u32x4 w;
      w.x = pk(oa[0], oa[1]); w.y = pk(oa[2], oa[3]); w.z = pk(oa[4], oa[5]); w.w = pk(oa[6], oa[7]); qr[8] = __builtin_bit_cast(bf16x8, w);
      w.x = pk(ob[0], ob[1]); w.y = pk(ob[2], ob[3]); w.z = pk(ob[4], ob[5]); w.w = pk(ob[6], ob[7]); qr[9] = __builtin_bit_cast(bf16x8, w);
      w.x = pk(oc[0], oc[1]); w.y = pk(oc[2], oc[3]); w.z = pk(oc[4], oc[5]); w.w = pk(oc[6], oc[7]); qr[10] = __builtin_bit_cast(bf16x8, w);
      w.x = pk(od[0], od[1]); w.y = pk(od[2], od[3]); w.z = pk(od[4], od[5]); w.w = pk(od[6], od[7]); qr[11] = __builtin_bit_cast(bf16x8, w);
  }
  const int sr = tid >> 4, sc = (tid & 15) * 8, vst0 = v_st(sr, sc), vst1 = v_st(32 + sr, sc);
  const int kr = tid >> 3, kc = (tid & 7) * 8;
  const int vb0 = (int)(uintptr_t)V_lds + v_rd_base(lane);
  bf16x8 vs0, vs1, ks0, ks1, kp0;
#define SLOAD(k0) do { const size_t ra = (size_t)krow(b, (k0) + sr) * 4096 + h * 256 + sc, rb2 = (size_t)krow(b, (k0) + 32 + sr) * 4096 + h * 256 + sc; \
    ks0 = *(const bf16x8*)(KV + ra); ks1 = *(const bf16x8*)(KV + rb2); vs0 = *(const bf16x8*)(KV + ra + 128); vs1 = *(const bf16x8*)(KV + rb2 + 128); \
    kp0 = *(const bf16x8*)(KP + (size_t)krow(b, (k0) + kr) * 64 + kc); } while (0)
#define SWRITE(bb) do { *(LAS bf16x8*)(V_lds + (bb) * SHM_V + vst0) = vs0; *(LAS bf16x8*)(V_lds + (bb) * SHM_V + vst1) = vs1; \
    *(LAS bf16x8*)(K_lds + (bb) * SHM_K + KSWZ(sr, sc * 2)) = ks0; *(LAS bf16x8*)(K_lds + (bb) * SHM_K + KSWZ(32 + sr, sc * 2)) = ks1; \
    *(LAS bf16x8*)(K_lds + (bb) * SHM_K + KSWZ(kr, 256 + kc * 2)) = kp0; } while (0)
  __syncthreads();
  SLOAD(0); SWRITE(0); __syncthreads();
  f32x16 p0, p1; float mn, al; bf16x8 pa0, pa1, pa2, pa3;
  for (int j = 0; j < NT; ++j) {
    const int bb = j & 1;
    if (j + 1 < NT) SLOAD((j + 1) * KVBLK);
    SBAR(); qkt(p0, p1, K_lds + bb * SHM_K, qr, r32, hi);
    partialSM(p0, p1, m_reg, mn, al);
    if (__any(al < 1.f)) { if (hi == 0) al_l[r32] = al; asm volatile("s_waitcnt lgkmcnt(0)" ::: "memory");
#pragma unroll
      for (int d = 0; d < 4; ++d)
#pragma unroll
        for (int r = 0; r < 16; ++r) o[d][r] *= al_l[crow(r, hi)]; }
    finishSM(p0, p1, al, l_reg, pa0, pa1, pa2, pa3); SBAR();
    pv_d0(o, vb0 + bb * SHM_V, pa0, pa1, pa2, pa3);
    if (j + 1 < NT) SWRITE(bb ^ 1);
    __syncthreads();
  }
  if (hi == 0) li_l[r32] = l_reg; asm volatile("s_waitcnt lgkmcnt(0)" ::: "memory");
  float rli[16];
#pragma unroll
  for (int r = 0; r < 16; ++r) rli[r] = __builtin_amdgcn_rcpf(li_l[crow(r, hi)]);
  unsigned char* Ow = (unsigned char*)Ob + ((size_t)(b * SEQ + qb * 256 + wid * 32)) * DM + h * 128;
#pragma unroll
  for (int r = 0; r < 16; ++r) { const int orow = crow(r, hi);
#pragma unroll
    for (int d0 = 0; d0 < 4; ++d0) { const unsigned w = pk8(clamp8(o[d0][r] * rli[r] * F8_OSCALE), 0.f, 0.f, 0.f); Ow[(size_t)orow * DM + d0 * 32 + r32] = (unsigned char)(w & 0xffu); } }
#undef SLOAD
#undef SWRITE
}
DI void phase(const Args& a, LAS unsigned char* lds, int G) {
  for (int u = blockIdx.x; u < NB * 16 * 16; u += G) {
    const int b = u >> 8, cc = u & 255, x = cc & 7, j = cc >> 3;
    unit(a, lds, b, 2 * x + (j >> 4), j & 15);
  }
  __syncthreads();
}
}

DI int balanced_grid(int nunits, int G) { if (nunits <= 0) return G; const int rounds = (nunits + G - 1) / G; return (nunits + rounds - 1) / rounds; }

template <bool F8, bool ACT8 = F8> DI void ph_moe_gu(const Args& a, int layer, int phase, LAS unsigned char* lds, int G) {
    unsigned char* ws = a.ws;
    moe_setup(a, layer, lds);
    const LAS int* tb256 = (const LAS int*)(lds + LCTL_OFF + 64); const LAS int* tbu = tb256; const LAS int* cn = (const LAS int*)(lds + LCTL_OFF + 256);
    const int GG = balanced_grid(tbu[32] * 16, G);
    if ((int)blockIdx.x >= GG) { cvq::service(a, lds, cvq::need(phase + 1), cvq::done_word(a, phase), 1u); return; }
    LAS unsigned* offs = (LAS unsigned*)(lds + TAB_OFF);
    constexpr int KE = F8 ? 1024 : 2048;
    typedef pg8::MoeSched<true, F8> SchedT; constexpr int RM = SchedT::RM;
    SchedT S; S.init(tbu, tb256, offs, 4096, KE, ws + WS_WGU + (size_t)layer * 32 * 4096 * 2048 * 2, GG, blockIdx.x); S.sig = cvq::done_word(a, phase);
    const int* ltok = (const int*)(ws + WS_LTOK);
    {
        const int nu = (S.nunits - S.c + GG - 1) / GG;
        for (int idx = threadIdx.x; idx < nu * RM; idx += 512) {
            const int ui = idx / RM, lr = idx - ui * RM; pg8::Unit u; S.next(ui, u);
            const int slot = u.aux + lr; const int tok = ltok[(size_t)u.e * TCAP + (slot < cn[u.e] ? slot : 0)];
            offs[idx] = (unsigned)tok * (unsigned)(KE * 2);
        }
        __syncthreads();
    }
    pg8::EpiGU<false, ACT8> E{(bf16_t*)(ws + WS_ACT), a.in[I_BGU] + (size_t)layer * 32 * 4096, F8 ? 1.0f / (F8_WSCALE * F8_ASCALE) : 1.0f};
    pg8::gemm_phase(lds, ws + WS_H2, KE, S, E);
    cvq::service(a, lds, cvq::need(phase + 1), nullptr, 0u);
}
template <bool F8> DI void ph_moe_dn(const Args& a, int layer, int phase, LAS unsigned char* lds, int G) {
    unsigned char* ws = a.ws;
    moe_setup(a, layer, lds);
    const LAS int* tb256 = (const LAS int*)(lds + LCTL_OFF + 64); const LAS int* tbu = tb256; const LAS int* cn = (const LAS int*)(lds + LCTL_OFF + 256);
    const int GG = balanced_grid(tbu[32] * 8, G);
    if ((int)blockIdx.x >= GG) { cvq::service(a, lds, cvq::need(phase + 1), cvq::done_word(a, phase), 1u); return; }
    constexpr int KE = F8 ? 1024 : 2048;
    pg8::MoeSched<false, F8> S; S.init(tbu, tb256, nullptr, 2048, KE, ws + WS_WDN + (size_t)layer * 32 * 2048 * 2048 * 2, GG, blockIdx.x); S.sig = cvq::done_word(a, phase);
    pg8::EpiDN<false> E{(bf16_t*)(ws + WS_Y2), a.in[I_BDN] + (size_t)layer * 32 * 2048, (const float*)(ws + WS_LGATE), cn, F8 ? 1.0f / (F8_WSCALE_DN * F8_ACTSCALE) : 1.0f};
    pg8::gemm_phase(lds, ws + WS_ACT, KE, S, E);
    cvq::service(a, lds, cvq::need(phase + 1), nullptr, 0u);
}

constexpr int N_PHASES = 19;
__global__ void __launch_bounds__(512, 2) mk_fwd(Args args) {
    extern __shared__ __attribute__((aligned(16))) unsigned char lds_raw[];
    LAS unsigned char* lds = (LAS unsigned char*)lds_raw;
    const int G = gridDim.x;
    unsigned char* ws = args.ws;
    for (int u = threadIdx.x; u < 256; u += 512) ((LAS unsigned*)(lds + LCTL_OFF))[u] = 0u;
    __syncthreads();
#if MK_PER_PHASE
#define GRID_BAR() do { } while (0)
#else
    XcdBarrier bar = xcd_barrier_post((unsigned*)(ws + WS_CTL), (volatile LAS unsigned*)(lds + LCTL_OFF));
#define GRID_BAR() xcd_barrier(bar)
#endif
    const int lo = args.ph_lo, hi = args.ph_hi;
#ifndef MK_MASK
#define MK_MASK 0xFFFFFFu
#endif
#define IN(k) (((MK_MASK >> (k)) & 1u) && lo <= (k) && (k) < hi)
#define SEAM(k) do { if (IN((k) + 1)) GRID_BAR(); } while (0)
    const float* modv = (const float*)(ws + WS_MODV);

#ifndef MK_REP
#define MK_REP 0u
#endif
#define PHASE(k, ...) do { if (IN(k)) { __VA_ARGS__; if ((MK_REP >> (k)) & 1u) { GRID_BAR(); __VA_ARGS__; } cvq::service(args, lds, cvq::need((k) + 1), nullptr, 0u); SEAM(k); } } while (0)
#define GEMM_PHASE(k, GG, M_, N_, ...) GEMM_PHASE_U(k, GG, ((M_) / 256) * ((N_) / 256), __VA_ARGS__)
#define GEMM_PHASE_U(k, GG, NU_, ...) do { if (IN(k)) { const int GG = balanced_grid((NU_), G); \
        if ((int)blockIdx.x < GG) { __VA_ARGS__; cvq::service(args, lds, cvq::need((k) + 1), nullptr, 0u); } \
        else cvq::service(args, lds, cvq::need((k) + 1), cvq::done_word(args, (k)), 1u); \
        SEAM(k); } } while (0)
    if (IN(0)) {
        if ((int)blockIdx.x < 192 || (int)blockIdx.x == G - 1) { p0_prologue(args, lds, G); cvq::signal_done(args, 0); cvq::service(args, lds, cvq::need(1), nullptr, 0u); }
        else cvq::service(args, lds, cvq::need(1), cvq::done_word(args, 0), 193u);
        SEAM(0);
    }
    PHASE(1, ph_modulate(args.in[I_X], args.in[I_CTX], modv, 0, 1, (bf16_t*)(ws + WS_H), G));
    GEMM_PHASE(2, GG, T, HGN, { pg8::PlainSched<true> S; S.init(T, HGN, 1024, ws + WS_WHGIN, GG, blockIdx.x); S.sig = cvq::done_word(args, 2);
               pg8::EpiHgIn E{(bf16_t*)(ws + WS_P), (const float*)(ws + WS_LB), 1.0f / (F8_WSCALE * F8_ASCALE)}; pg8::gemm_phase(lds, ws + WS_H, 1024, S, E); });
    if (IN(3)) {
        if ((int)blockIdx.x < hg::NCHAIN) { hg::scan(args, lds, hg::NCHAIN); cvq::signal_done(args, 3); cvq::service(args, lds, cvq::need(4), nullptr, 0u); }
        else cvq::service(args, lds, cvq::need(4), cvq::done_word(args, 3), (unsigned)hg::NCHAIN);
        SEAM(3);
    }
    PHASE(4, ph_hg_combine(args, G));
    GEMM_PHASE_U(5, GG, (T / 256) * 8, { pg8::PlainSched<true> S; S.init(T, 2048, 1024, ws + WS_WHGO, GG, blockIdx.x); S.sig = cvq::done_word(args, 5);
               pg8::EpiBf16<false> E{(bf16_t*)(ws + WS_Y), 2048, 2048, 1.0f / (F8_WSCALE_DN * F8_OGSCALE)}; pg8::gemm_phase(lds, ws + WS_OG, 1024, S, E); });
    PHASE(6, ph_post_router(args, 0, args.in[I_X], args.in[I_CTX], (const bf16_t*)(ws + WS_Y), T, lds, G));
    if (IN(7)) { ph_moe_gu<true>(args, 0, 7, lds, G); SEAM(7); }
    if (IN(8)) { ph_moe_dn<true>(args, 0, 8, lds, G); SEAM(8); }
    PHASE(9, ph_post_ffn(args, 0, T, (float*)(ws + WS_X2), true, lds, G));
    GEMM_PHASE(10, GG, T, 1280, { pg8::PlainSched<> S; S.init(T, 1280, 2048, ws + WS_WMIN, GG, blockIdx.x); S.sig = cvq::done_word(args, 10); pg8::EpiF32 E{(float*)(ws + WS_PM), 1088, 1088};
                pg8::gemm_phase(lds, ws + WS_H, 2048, S, E); });
    PHASE(11, ph_mla_local(args, G));
    PHASE(12, { { pg8::PlainSched<> S; S.init(TL, 3072, 512, ws + WS_WUQ, G, blockIdx.x); pg8::EpiBf16<> E{(bf16_t*)(ws + WS_Q), 3072, 3072, 1.0f}; pg8::gemm_phase(lds, ws + WS_CQN, 512, S, E); }
                { pg8::PlainSched<> S; S.init(T, 4096, 512, ws + WS_WUKV, G, blockIdx.x); pg8::EpiBf16<> E{(bf16_t*)(ws + WS_KV), 4096, 4096, 1.0f}; pg8::gemm_phase(lds, ws + WS_CKVN, 512, S, E); } });
    PHASE(13, att::phase(args, lds, G));
    PHASE(14, { pg8::PlainSched<true> S; S.init(TL, 2048, 1024, ws + WS_WMO, G, blockIdx.x); pg8::EpiBf16<false> E{(bf16_t*)(ws + WS_Y), 2048, 2048, 1.0f / (F8_WSCALE_DN * F8_OSCALE)};
                pg8::gemm_phase(lds, ws + WS_OG, 1024, S, E); });
    PHASE(15, ph_post_router(args, 1, (const float*)(ws + WS_X2), (const float*)(ws + WS_X2) + (size_t)TL * DM, (const bf16_t*)(ws + WS_Y), TL, lds, G));
    if (IN(16)) { ph_moe_gu<true>(args, 1, 16, lds, G); SEAM(16); }
    if (IN(17)) { ph_moe_dn<true>(args, 1, 17, lds, G); SEAM(17); }
    if (IN(18)) { ph_post_ffn(args, 1, TL, args.out, false, lds, G); if ((MK_REP >> 18) & 1u) { GRID_BAR(); ph_post_ffn(args, 1, TL, args.out, false, lds, G); } }
#undef GEMM_PHASE
#undef GEMM_PHASE_U
#undef PHASE
#undef IN
#undef SEAM
}

extern "C" void kernel_launch(void* const* d_in, const int* in_sizes, int n_in, void* d_out, int out_size, void* d_ws, size_t ws_size, hipStream_t stream) {
    static int grid = 0;
    if (grid == 0) {
        if (n_in != 24 || out_size != TL * DM || ws_size < WS_END) { fprintf(stderr, "kernel_launch: shape mismatch: n_in %d out %d ws %zu (need %zu)\n", n_in, out_size, ws_size, (size_t)WS_END); grid = -1; return; }
        int dev = 0, cus = 0, per_cu = 0;
        if (hipGetDevice(&dev) != hipSuccess || hipDeviceGetAttribute(&cus, hipDeviceAttributeMultiprocessorCount, dev) != hipSuccess) { grid = -1; return; }
        if (hipFuncSetAttribute((const void*)mk_fwd, hipFuncAttributeMaxDynamicSharedMemorySize, LDS_BYTES) != hipSuccess) { fprintf(stderr, "kernel_launch: hipFuncSetAttribute failed\n"); grid = -1; return; }
        if (hipOccupancyMaxActiveBlocksPerMultiprocessor(&per_cu, (const void*)mk_fwd, 512, LDS_BYTES) != hipSuccess || per_cu < 1) fprintf(stderr, "kernel_launch: occupancy query reports %d\n", per_cu);
        (void)hipGetLastError();
        grid = cus;
        if (grid != 256) { fprintf(stderr, "kernel_launch: built for 256 CUs, device has %d\n", cus); grid = -1; return; }
    }
    if (grid < 0) return;
    (void)hipMemsetAsync((char*)d_ws + WS_CTL, 0, CTL_BYTES, stream);
    Args a{};
    for (int i = 0; i < 24; ++i) a.in[i] = (const float*)d_in[i];
    a.out = (float*)d_out; a.ws = (unsigned char*)d_ws;
#if MK_PER_PHASE
    for (int p = 0; p < N_PHASES; ++p) { a.ph_lo = p; a.ph_hi = p + 1; hipLaunchKernelGGL(mk_fwd, dim3(grid), dim3(512), LDS_BYTES, stream, a); }
#else
    a.ph_lo = 0; a.ph_hi = N_PHASES;
    hipLaunchKernelGGL(mk_fwd, dim3(grid), dim3(512), LDS_BYTES, stream, a);
#endif
    const hipError_t le = hipPeekAtLastError();
    if (le != hipSuccess) fprintf(stderr, "kernel_launch: launch failed: %s\n", hipGetErrorName(le));
}
```

```cpp
#include <hip/hip_runtime.h>
#include <stdio.h>
#include <stdint.h>

#ifndef MK_PER_PHASE
#define MK_PER_PHASE 0
#endif

#define LAS __attribute__((address_space(3)))
#define DI __device__ __forceinline__
typedef unsigned short bf16_t;
typedef short bf16x8 __attribute__((ext_vector_type(8)));
typedef short s16x4 __attribute__((ext_vector_type(4)));
typedef float f32x2 __attribute__((ext_vector_type(2)));
typedef float f32x4 __attribute__((ext_vector_type(4)));
typedef float f32x16 __attribute__((ext_vector_type(16)));
typedef unsigned u32x2 __attribute__((ext_vector_type(2)));
typedef unsigned u32x4 __attribute__((ext_vector_type(4)));
typedef __bf16 bfv2 __attribute__((ext_vector_type(2)));

typedef int v4i __attribute__((ext_vector_type(4)));
typedef int v8i __attribute__((ext_vector_type(8)));
constexpr float F8_WSCALE = 256.0f, F8_ASCALE = 8.0f, F8_WSCALE_DN = 512.0f, F8_ACTSCALE = 4.0f, F8_OGSCALE = 8.0f, F8_OSCALE = 32.0f;
DI float clamp8(float x) { return __builtin_amdgcn_fmed3f(x, -440.0f, 440.0f); }
DI unsigned pk8(float a, float b, float c, float d) { int w = __builtin_amdgcn_cvt_pk_fp8_f32(a, b, 0, false); w = __builtin_amdgcn_cvt_pk_fp8_f32(c, d, w, true); return (unsigned)w; }
DI unsigned pk(float a, float b) { f32x2 v = {a, b}; bfv2 r = __builtin_convertvector(v, bfv2); return __builtin_bit_cast(unsigned, r); }
DI float bf_lo(unsigned w) { return __uint_as_float(w << 16); }
DI float bf_hi(unsigned w) { return __uint_as_float(w & 0xffff0000u); }
DI float wave_sum(float v) { for (int o = 32; o >= 1; o >>= 1) v += __shfl_xor(v, o); return v; }
DI float sigm(float x) { return __builtin_amdgcn_rcpf(1.0f + __expf(-x)); }
DI int tid_() { int t = threadIdx.x; asm volatile("" : "+v"(t)); return t; }

constexpr int DM = 2048, NB = 4, SEQ = 4096, LC = 256, TL = NB * SEQ, TCX = NB * LC, T = TL + TCX, LSEQ = SEQ + LC;
constexpr int NE = 32, TCAP = T, HGN = 10240, MAXRT = 304, NMOD = 12288;
constexpr float DN_ALPHA = 1.4142135623730951f;
constexpr float LN_EPS = 1e-5f, RMS_EPS = 1e-6f;

constexpr size_t al256(size_t x) { return (x + 255) / 256 * 256; }
constexpr size_t WS_CTL = 0, CTL_BYTES = 65536;
constexpr size_t CTL_CNT0 = 16384, CTL_CNT1 = 24576;
constexpr size_t WS_MODV = WS_CTL + CTL_BYTES;
constexpr size_t WS_LB = WS_MODV + al256((size_t)2 * 5 * NMOD * 4);
constexpr size_t WS_ROPE = WS_LB + al256(2 * 2048 * 4);
constexpr size_t WS_WGU = WS_ROPE + al256(64 * 16 * 2 * 4);
constexpr size_t WS_WDN = WS_WGU + (size_t)2 * 32 * 4096 * 2048 * 2;
constexpr size_t WS_WHGIN = WS_WDN + (size_t)2 * 32 * 2048 * 2048 * 2;
constexpr size_t WS_WHGO = WS_WHGIN + (size_t)HGN * 2048 * 2;
constexpr size_t WS_WMIN = WS_WHGO + (size_t)2048 * 2048 * 2;
constexpr size_t WS_WUQ = WS_WMIN + (size_t)1280 * 2048 * 2;
constexpr size_t WS_WUKV = WS_WUQ + (size_t)3072 * 512 * 2;
constexpr size_t WS_WMO = WS_WUKV + (size_t)4096 * 512 * 2;
constexpr size_t WS_H = WS_WMO + (size_t)2048 * 2048 * 2;
constexpr size_t WS_P = WS_H + (size_t)T * 2048 * 2;
constexpr size_t WS_OF = WS_P + (size_t)T * HGN * 2;
constexpr size_t WS_OB = WS_OF + (size_t)T * 2048 * 2;
constexpr size_t WS_OG = WS_OB + (size_t)T * 2048 * 2;
constexpr size_t WS_Y = WS_OG + (size_t)T * 2048 * 2;
constexpr size_t WS_X1 = WS_Y + (size_t)T * 2048 * 2;
constexpr size_t WS_X2 = WS_X1 + (size_t)T * 2048 * 4;
constexpr size_t WS_H2 = WS_X2 + (size_t)T * 2048 * 4;
constexpr size_t WS_LTOK = WS_H2 + (size_t)T * 2048 * 2;
constexpr size_t WS_LGATE = WS_LTOK + al256((size_t)NE * TCAP * 4);
constexpr size_t WS_TOKES = WS_LGATE + al256((size_t)NE * TCAP * 4);
constexpr size_t WS_ACT = WS_TOKES + al256((size_t)T * 4 * 4);
constexpr size_t WS_Y2 = WS_ACT + (size_t)MAXRT * 256 * 2048 * 2;
constexpr size_t WS_PM = WS_Y2 + (size_t)MAXRT * 256 * 2048 * 2;
constexpr size_t WS_CQN = WS_PM + al256((size_t)T * 1088 * 4);
constexpr size_t WS_CKVN = WS_CQN + (size_t)TL * 512 * 2;
constexpr size_t WS_KP = WS_CKVN + (size_t)T * 512 * 2;
constexpr size_t WS_Q = WS_KP + (size_t)T * 64 * 2;
constexpr size_t WS_KV = WS_Q + (size_t)TL * 3072 * 2;
constexpr size_t WS_END = WS_KV + (size_t)T * 4096 * 2;

constexpr int RING_BYTES = 131072, TAB_OFF = 131072, TAB_BYTES = 24576, LCTL_OFF = TAB_OFF + TAB_BYTES, LDS_BYTES = LCTL_OFF + 1024;

#define XB_TMO      128
#define XB_XCNT(j)  (256  + 64 * (j))
#define XB_XSUB(j)  (1280 + 64 * (j))
#define XB_XGEN(j)  (2304 + 64 * (j))
#define XB_TOP      3328
#define XB_TOPGEN   3392
#define XCD_BAR_WORDS 3456
#define XB_SPIN_CAP (1u << 22)

__device__ __forceinline__ unsigned xb_ld(unsigned* p)              { return __hip_atomic_load(p, __ATOMIC_RELAXED, __HIP_MEMORY_SCOPE_AGENT); }
__device__ __forceinline__ unsigned xb_add(unsigned* p, unsigned v) { return __hip_atomic_fetch_add(p, v, __ATOMIC_RELAXED, __HIP_MEMORY_SCOPE_AGENT); }
__device__ __forceinline__ unsigned xb_xcc_id() { return (unsigned)__builtin_amdgcn_s_getreg((3 << 11) | 20) & 0xFu; }
#define XB_SPIN(cond, bar) do { unsigned _sp = 0; while (cond) { __builtin_amdgcn_s_sleep(1); \
    if ((++_sp & 255u) == 0u) { if (xb_ld(&(bar)[XB_TMO])) break; if (_sp > XB_SPIN_CAP) { atomicAdd(&(bar)[XB_TMO], 1u); break; } } } } while (0)

struct XcdBarrier { unsigned* bar; unsigned x; volatile LAS unsigned* st; };

__device__ __forceinline__ XcdBarrier xcd_barrier_post(unsigned* bar, volatile LAS unsigned* st) {
    XcdBarrier b; b.bar = bar; b.x = xb_xcc_id(); b.st = st;
    if (threadIdx.x == 0) (void)xb_add(&bar[XB_XCNT(b.x)], 1u);
    return b;
}
__device__ __forceinline__ void xcd_barrier_complete(unsigned* bar, unsigned x, unsigned& nloc, unsigned& nx) {
    const unsigned G = gridDim.x * gridDim.y * gridDim.z;
    unsigned sum, cnt, mine, sp = 0u;
    for (;;) {
        sum = 0u; cnt = 0u; mine = 0u;
#pragma unroll
        for (unsigned j = 0; j < 16; ++j) { const unsigned c = xb_ld(&bar[XB_XCNT(j)]); sum += c; cnt += (c > 0u) ? 1u : 0u; mine = (j == x) ? c : mine; }
        if (sum == G) break;
        __builtin_amdgcn_s_sleep(1);
        if ((++sp & 255u) == 0u) { if (xb_ld(&bar[XB_TMO])) break; if (sp > XB_SPIN_CAP) { atomicAdd(&bar[XB_TMO], 1u); break; } }
    }
    nloc = mine > 0u ? mine : 1u; nx = cnt > 0u ? cnt : 1u;
}
__device__ __forceinline__ void xcd_barrier(const XcdBarrier& b) {
    asm volatile("s_waitcnt vmcnt(0)" ::: "memory");
    __syncthreads();
    if (threadIdx.x == 0) {
        unsigned* bar = b.bar;
        __builtin_amdgcn_s_waitcnt(0);
        unsigned nloc = b.st[0], nx = b.st[1];
        if (nloc == 0u) { xcd_barrier_complete(bar, b.x, nloc, nx); b.st[0] = nloc; b.st[1] = nx; }
        const unsigned old = xb_add(&bar[XB_XSUB(b.x)], 1u);
        const unsigned gen = old / nloc;
        if (old + 1u == (gen + 1u) * nloc) {
            __builtin_amdgcn_fence(__ATOMIC_RELEASE, "agent");
            asm volatile("s_waitcnt vmcnt(0)" ::: "memory");
            const unsigned og = xb_add(&bar[XB_TOP], 1u);
            const unsigned tg = og / nx;
            if (og + 1u == (tg + 1u) * nx) xb_add(&bar[XB_TOPGEN], 1u);
            else XB_SPIN(xb_ld(&bar[XB_TOPGEN]) == tg, bar);
            __builtin_amdgcn_fence(__ATOMIC_ACQUIRE, "agent");
            xb_add(&bar[XB_XGEN(b.x)], 1u);
            asm volatile("s_waitcnt vmcnt(0)" ::: "memory");
        } else {
            XB_SPIN(xb_ld(&bar[XB_XGEN(b.x)]) == gen, bar);
            __builtin_amdgcn_fence(__ATOMIC_ACQUIRE, "agent");
            asm volatile("s_waitcnt vmcnt(0)" ::: "memory");
        }
    }
    __syncthreads();
}

namespace pg8 {
constexpr int BM = 256, BK = 64, HALF = 128, HTB = HALF * BK * 2, NXCD = 8, WGM = 8;
DI int lds_byte(int r, int c) { const int st = (r >> 4) * 2 + (c >> 5), rr = r & 15, cc = c & 31, ob = rr * 64 + cc * 2; return st * 1024 + (ob ^ (((ob >> 9) & 1) << 5)); }
DI void stage_rc(int b, int& R, int& C) { const int st = b / 1024, sb = b % 1024, swz = sb ^ (((sb >> 9) & 1) << 5); R = (st >> 1) * 16 + swz / 64; C = (st & 1) * 32 + (swz % 64) / 2; }
DI int perm32(int rho) { const int n = rho >> 4, i = rho & 15; return 8 * (i >> 2) + 4 * n + (i & 3); }

struct Unit { const char* B; int row0, col0, e, aux; };

template <bool FP8_ = false> struct PlainSched {
    static constexpr int RM = 256;
    int nM, nN, nwg, G, c, K; const char* Bt; unsigned* sig = nullptr;
    DI void init(int M, int N, int K_, const void* Bt_, int G_, int c_) { nM = M / RM; nN = N / BM; nwg = nM * nN; G = G_; c = c_; K = K_; Bt = (const char*)Bt_; }
    DI bool next(int i, Unit& u) const {
        const long L = (long)i * G + c; if (L >= nwg) return false;
        int wgid = (int)L; { const int q = nwg / NXCD, r = nwg % NXCD, xcd = wgid % NXCD, off = wgid / NXCD; wgid = (xcd < r ? xcd * (q + 1) : r * (q + 1) + (xcd - r) * q) + off; }
        const int nig = WGM * nN, gid = wgid / nig, fm = gid * WGM, gsz = (nM - fm) < WGM ? (nM - fm) : WGM;
        const int pm = fm + ((wgid % nig) % gsz), pn = (wgid % nig) / gsz;
        u.row0 = pm * RM; u.col0 = pn * BM; u.e = 0; u.aux = 0; u.B = Bt + (size_t)pn * BM * K * 2; return true;
    }
    static constexpr bool GATHER = false, FP8 = FP8_, HM = false;
    DI void avoff(int, const Unit&, const int (&)[2], const int (&)[2], unsigned (&)[2][2]) const {}
};
template <bool GATHER_, bool FP8_ = false> struct MoeSched {
    static constexpr bool GATHER = GATHER_, FP8 = FP8_, HM = false;
    static constexpr int RM = HM ? 128 : 256;
    const LAS int* tb; const LAS int* tb256; const LAS unsigned* offs; int NT, nunits, G, c, K, N; const char* Wt; unsigned* sig = nullptr;
    DI void init(const LAS int* tb_, const LAS int* tb256_, const LAS unsigned* offs_, int N_, int K_, const void* Wt_, int G_, int blk) {
        tb = tb_; tb256 = tb256_; offs = offs_; N = N_; K = K_; NT = N_ / BM; Wt = (const char*)Wt_; G = G_; nunits = tb_[32] * NT;
        { const int q = G_ / 8, r = G_ % 8, x = blk % 8; c = x * q + (x < r ? x : r) + blk / 8; }
    }
    DI bool next(int i, Unit& u) const {
        const int L = i * G + c; if (L >= nunits) return false;
        int rt = L / NT, pn = L - rt * NT;
        if (NT == 16 && L < 64 * (tb[32] >> 2)) { const int g = L >> 6, sub = L & 63; rt = 4 * g + ((sub & 31) >> 3); pn = (sub >> 5) * 8 + (sub & 7); }
        int e = 0;
#pragma unroll
        for (int st = 16; st >= 1; st >>= 1) e += (tb[e + st] <= rt) ? st : 0;
        e = __builtin_amdgcn_readfirstlane(e);
        u.e = e; u.aux = __builtin_amdgcn_readfirstlane((rt - tb[e]) * RM); u.row0 = __builtin_amdgcn_readfirstlane(tb256[e]) * BM + u.aux; u.col0 = pn * BM; u.B = Wt + ((size_t)e * N + (size_t)pn * BM) * K * 2; return true;
    }
    DI void avoff(int ui, const Unit&, const int (&R)[2], const int (&C)[2], unsigned (&vo)[2][2]) const {
#pragma unroll
        for (int h = 0; h < 2; ++h)
#pragma unroll
            for (int i = 0; i < 2; ++i) vo[h][i] = offs[ui * RM + (HM ? 0 : h * HALF) + R[i]] + (unsigned)C[i] * 2u;
    }
};

template <class Epi, class Sched>
DI void gemm_phase(LAS unsigned char* lds, const void* Abase_, int K, const Sched& S, const Epi& E) {
    const char* Abase = (const char*)Abase_;
    const int tid = tid_(), wid = __builtin_amdgcn_readfirstlane(tid >> 6), lane = tid & 63, wr = wid >> 2, wc = wid & 3, fr = lane & 15, fq = lane >> 4;
    const int nt = K / BK;
    int R[2], C[2]; unsigned voffB[2];
#pragma unroll
    for (int i = 0; i < 2; ++i) { stage_rc(tid * 16 + i * 8192, R[i], C[i]); const int Rb = (R[i] & ~31) + perm32(R[i] & 31); voffB[i] = (unsigned)(Rb * K + C[i]) * 2u; }
    const size_t kstep = (size_t)(BK * 2);
    const size_t hstep = (size_t)HALF * K * 2;
    const unsigned ldsw = (unsigned)wid * 1024u;
    const int aoff = lds_byte(wr * 64 + fr, fq * 8), boff = lds_byte(wc * 32 + fr, fq * 8);
#define PG8_SA(b, h) (((b) * 2 + (h)) * HTB)
#define PG8_SB(b, h) ((4 + (b) * 2 + (h)) * HTB)
#define PG8_STAGE(bufoff, gbase, voff) do { const char* gb_; { const unsigned long long t_ = (unsigned long long)(gbase); unsigned lo_ = __builtin_amdgcn_readfirstlane((unsigned)t_), hi_ = __builtin_amdgcn_readfirstlane((unsigned)(t_ >> 32)); \
        asm volatile("" : "+s"(lo_), "+s"(hi_)); gb_ = (const char*)(((unsigned long long)hi_ << 32) | lo_); }     \
        _Pragma("unroll") for (int _i = 0; _i < 2; ++_i) \
        __builtin_amdgcn_global_load_lds((const unsigned*)(gb_ + (voff)[_i]), (LAS unsigned*)(lds + (bufoff) + ldsw + _i * 8192), 16, 0, 0); } while (0)
#define PG8_LDA(dst, b, h) do { if constexpr (Sched::FP8) { const LAS unsigned char* p_ = lds + PG8_SA(b, h) + aoff; _Pragma("unroll") for (int m = 0; m < 4; ++m) \
            dst##8[m] = __builtin_shufflevector(*(const LAS v4i*)(p_ + m * 2048), *(const LAS v4i*)(p_ + m * 2048 + 1024), 0, 1, 2, 3, 4, 5, 6, 7); } \
        else { _Pragma("unroll") for (int m = 0; m < 4; ++m) _Pragma("unroll") for (int k = 0; k < 2; ++k) dst[m][k] = *(const LAS bf16x8*)(lds + PG8_SA(b, h) + aoff + m * 2048 + k * 1024); } } while (0)
#define PG8_LDB(dst, b, h) do { if constexpr (Sched::FP8) { const LAS unsigned char* p_ = lds + PG8_SB(b, h) + boff; _Pragma("unroll") for (int n = 0; n < 2; ++n) \
            dst##8[n] = __builtin_shufflevector(*(const LAS v4i*)(p_ + n * 2048), *(const LAS v4i*)(p_ + n * 2048 + 1024), 0, 1, 2, 3, 4, 5, 6, 7); } \
        else { _Pragma("unroll") for (int n = 0; n < 2; ++n) _Pragma("unroll") for (int k = 0; k < 2; ++k) dst[n][k] = *(const LAS bf16x8*)(lds + PG8_SB(b, h) + boff + n * 2048 + k * 1024); } } while (0)
#define PG8_MMA(ai, bj, At, Bt) do { __builtin_amdgcn_s_setprio(1); \
        if constexpr (Sched::FP8) { _Pragma("unroll") for (int m = 0; m < 4; ++m) _Pragma("unroll") for (int n = 0; n < 2; ++n) \
            acc[ai][bj][m][n] = __builtin_amdgcn_mfma_scale_f32_16x16x128_f8f6f4(Bt##8[n], At##8[m], acc[ai][bj][m][n], 0, 0, 0, 0, 0, 0); } \
        else { _Pragma("unroll") for (int m = 0; m < 4; ++m) _Pragma("unroll") for (int n = 0; n < 2; ++n) _Pragma("unroll") for (int k = 0; k < 2; ++k) \
            acc[ai][bj][m][n] = __builtin_amdgcn_mfma_f32_16x16x32_bf16(Bt[n][k], At[m][k], acc[ai][bj][m][n], 0, 0, 0); } \
        __builtin_amdgcn_s_setprio(0); } while (0)
#define PG8_MMAZ(ai, bj, At, Bt, zc) do { __builtin_amdgcn_s_setprio(1); \
        if (zc) { const f32x4 z_ = {0.f, 0.f, 0.f, 0.f}; _Pragma("unroll") for (int m = 0; m < 4; ++m) _Pragma("unroll") for (int n = 0; n < 2; ++n) \
            acc[ai][bj][m][n] = __builtin_amdgcn_mfma_scale_f32_16x16x128_f8f6f4(Bt##8[n], At##8[m], z_, 0, 0, 0, 0, 0, 0); }     \
        else { _Pragma("unroll") for (int m = 0; m < 4; ++m) _Pragma("unroll") for (int n = 0; n < 2; ++n) \
            acc[ai][bj][m][n] = __builtin_amdgcn_mfma_scale_f32_16x16x128_f8f6f4(Bt##8[n], At##8[m], acc[ai][bj][m][n], 0, 0, 0, 0, 0, 0); } \
        __builtin_amdgcn_s_setprio(0); } while (0)
#define PG8_WAIT_V(n) asm volatile("s_waitcnt vmcnt(" #n ")" ::: "memory")
#define PG8_WAIT_L(n) asm volatile("s_waitcnt lgkmcnt(" #n ")" ::: "memory")
#define PG8_BAR __builtin_amdgcn_s_barrier()
#define PG8_SCHED __builtin_amdgcn_sched_barrier(0)
    Unit cur, nxt; int ui = 0;
    if (!S.next(0, cur)) return;
    f32x4 acc[2][2][4][2];
#pragma unroll
    for (int a = 0; a < 2; ++a)
#pragma unroll
        for (int b = 0; b < 2; ++b)
#pragma unroll
            for (int m = 0; m < 4; ++m)
#pragma unroll
                for (int n = 0; n < 2; ++n) acc[a][b][m][n] = (f32x4){0.f, 0.f, 0.f, 0.f};
    bf16x8 At[4][2], B0[2][2], B1[2][2];
    v8i At8[4], B08[2], B18[2];
    constexpr bool GA = Sched::GATHER, HM = Sched::HM;
    unsigned voffA[2];
#pragma unroll
    for (int i = 0; i < 2; ++i) voffA[i] = (unsigned)(R[i] * K + C[i]) * 2u;
    unsigned cvo[2][2];
    if constexpr (GA) S.avoff(0, cur, R, C, cvo);
    const size_t tstepA = (size_t)K * 2;
    const char* cA = GA ? Abase : Abase + (size_t)cur.row0 * tstepA;
    const char* cB = cur.B;
#define PG8_STAGE_A(bufoff, ab, vo, h, kb) do { if constexpr (GA) { PG8_STAGE(bufoff, Abase + (kb), (vo)[h]); } else { PG8_STAGE(bufoff, (ab) + (size_t)(h) * hstep + (kb), voffA); } } while (0)
    if constexpr (HM) {
        PG8_STAGE(PG8_SB(0, 0), cB, voffB); PG8_STAGE_A(PG8_SA(0, 0), cA, cvo, 0, 0); PG8_STAGE(PG8_SB(0, 1), cB + hstep, voffB);
        if (wr == 1) PG8_BAR;
        PG8_WAIT_V(0); PG8_BAR;
        PG8_STAGE(PG8_SB(1, 0), cB + kstep, voffB); PG8_STAGE_A(PG8_SA(1, 0), cA, cvo, 0, kstep);
        PG8_WAIT_V(6); PG8_BAR;
    } else if constexpr (Sched::FP8) {
        PG8_STAGE_A(PG8_SA(0, 0), cA, cvo, 0, 0); PG8_STAGE(PG8_SB(0, 1), cB + hstep, voffB); PG8_STAGE_A(PG8_SA(0, 1), cA, cvo, 1, 0); PG8_STAGE(PG8_SB(0, 0), cB, voffB);
        PG8_STAGE_A(PG8_SA(1, 0), cA, cvo, 0, kstep); PG8_STAGE(PG8_SB(1, 1), cB + hstep + kstep, voffB); PG8_STAGE_A(PG8_SA(1, 1), cA, cvo, 1, kstep);
        if (wr == 1) PG8_BAR;
        PG8_WAIT_V(6); PG8_BAR; PG8_BAR;
    } else {
        PG8_STAGE(PG8_SB(0, 0), cB, voffB); PG8_STAGE(PG8_SB(0, 1), cB + hstep, voffB); PG8_STAGE_A(PG8_SA(0, 0), cA, cvo, 0, 0); PG8_STAGE_A(PG8_SA(0, 1), cA, cvo, 1, 0);
        if (wr == 1) PG8_BAR;
        PG8_WAIT_V(2); PG8_BAR;
        PG8_STAGE(PG8_SB(1, 0), cB + kstep, voffB); PG8_STAGE_A(PG8_SA(1, 0), cA, cvo, 0, kstep); PG8_STAGE(PG8_SB(1, 1), cB + hstep + kstep, voffB);
        PG8_WAIT_V(6); PG8_BAR;
    }
    for (;;) {
        const bool has_next = S.next(ui + 1, nxt);
        if (!has_next && S.sig != nullptr && blockIdx.x == 0 && threadIdx.x == 0) __hip_atomic_fetch_add(S.sig, 1u, __ATOMIC_RELAXED, __HIP_MEMORY_SCOPE_AGENT);
        const char* nB = has_next ? nxt.B : cB;
        const char* nA = GA ? Abase : (has_next ? Abase + (size_t)nxt.row0 * tstepA : cA);
        for (int t = 0; t < nt; t += 2) {
            const bool last = (t == nt - 2);
            const size_t k1 = (size_t)(t + 1) * kstep, k2 = last ? 0 : (size_t)(t + 2) * kstep, k3 = k2 + kstep;
            const char* a2 = last ? nA : cA; const char* b2 = (last ? nB : cB) + k2; const char* b3 = b2 + kstep;
            unsigned v2[2][2];
            if constexpr (GA) {
                if (last && has_next) S.avoff(ui + 1, nxt, R, C, v2);
                else {
#pragma unroll
                    for (int h = 0; h < 2; ++h)
#pragma unroll
                        for (int i = 0; i < 2; ++i) v2[h][i] = cvo[h][i];
                }
            }
            if constexpr (HM) {
            PG8_LDB(B0, 0, 0); PG8_SCHED; PG8_LDA(At, 0, 0); PG8_STAGE(PG8_SB(1, 1), cB + hstep + k1, voffB);
            PG8_WAIT_V(6); PG8_WAIT_L(0); PG8_BAR; PG8_MMA(0, 0, At, B0); PG8_BAR; PG8_SCHED;
            PG8_LDB(B1, 0, 1); PG8_STAGE(PG8_SB(0, 0), b2, voffB); PG8_STAGE_A(PG8_SA(0, 0), a2, v2, 0, k2);
            PG8_WAIT_V(6); PG8_WAIT_L(0); PG8_BAR; PG8_MMA(0, 1, At, B1); PG8_BAR; PG8_SCHED;
            PG8_LDB(B0, 1, 0); PG8_SCHED; PG8_LDA(At, 1, 0); PG8_STAGE(PG8_SB(0, 1), b2 + hstep, voffB);
            PG8_WAIT_V(6); PG8_WAIT_L(0); PG8_BAR; PG8_MMA(0, 0, At, B0); PG8_BAR; PG8_SCHED;
            PG8_LDB(B1, 1, 1); PG8_STAGE(PG8_SB(1, 0), b3, voffB); PG8_STAGE_A(PG8_SA(1, 0), a2, v2, 0, k3);
            PG8_WAIT_V(6); PG8_WAIT_L(0); PG8_BAR; PG8_MMA(0, 1, At, B1); PG8_BAR; PG8_SCHED;
            } else if constexpr (Sched::FP8) {
#define F8_KTILE(b, sB0n, aX, vX, kX, sB1x, zc) \
            PG8_LDB(B0, b, 0); PG8_SCHED; PG8_LDA(At, b, 0); PG8_STAGE(PG8_SB(1 - (b), 0), sB0n, voffB); \
            PG8_WAIT_V(12); PG8_WAIT_L(0); PG8_BAR; PG8_MMAZ(0, 0, At, B0, zc); PG8_BAR; PG8_SCHED; \
            PG8_LDB(B1, b, 1); PG8_STAGE_A(PG8_SA(b, 0), aX, vX, 0, kX); \
            PG8_WAIT_V(12); PG8_WAIT_L(0); PG8_BAR; PG8_MMAZ(0, 1, At, B1, zc); PG8_BAR; PG8_SCHED; \
            PG8_LDA(At, b, 1); PG8_STAGE(PG8_SB(b, 1), sB1x, voffB); \
            PG8_WAIT_V(12); PG8_WAIT_L(0); PG8_BAR; PG8_MMAZ(1, 1, At, B1, zc); PG8_BAR; PG8_SCHED; \
            PG8_LDB(B0, b, 0); PG8_STAGE_A(PG8_SA(b, 1), aX, vX, 1, kX); \
            PG8_WAIT_V(6); PG8_WAIT_L(0); PG8_BAR; PG8_MMAZ(1, 0, At, B0, zc); PG8_BAR; PG8_SCHED;
            F8_KTILE(0, cB + k1, a2, v2, k2, b2 + hstep, (t == 0))
            F8_KTILE(1, b2, a2, v2, k3, b3 + hstep, false)
#undef F8_KTILE
            } else {
            PG8_LDB(B0, 0, 0); PG8_LDB(B1, 0, 1); PG8_SCHED; PG8_LDA(At, 0, 0); PG8_STAGE_A(PG8_SA(1, 1), cA, cvo, 1, k1);
            PG8_WAIT_V(8); PG8_WAIT_L(0); PG8_BAR; PG8_MMA(0, 0, At, B0); PG8_MMA(0, 1, At, B1); PG8_BAR; PG8_SCHED;
            PG8_LDA(At, 0, 1); PG8_STAGE(PG8_SB(0, 0), b2, voffB); PG8_STAGE(PG8_SB(0, 1), b2 + hstep, voffB); PG8_STAGE_A(PG8_SA(0, 0), a2, v2, 0, k2);
            PG8_WAIT_V(8); PG8_WAIT_L(0); PG8_BAR; PG8_MMA(1, 0, At, B0); PG8_MMA(1, 1, At, B1); PG8_BAR; PG8_SCHED;
            PG8_LDB(B0, 1, 0); PG8_LDB(B1, 1, 1); PG8_SCHED; PG8_LDA(At, 1, 0); PG8_STAGE_A(PG8_SA(0, 1), a2, v2, 1, k2);
            PG8_WAIT_V(8); PG8_WAIT_L(0); PG8_BAR; PG8_MMA(0, 0, At, B0); PG8_MMA(0, 1, At, B1); PG8_BAR; PG8_SCHED;
            PG8_LDA(At, 1, 1); PG8_STAGE(PG8_SB(1, 0), b3, voffB); PG8_STAGE(PG8_SB(1, 1), b3 + hstep, voffB); PG8_STAGE_A(PG8_SA(1, 0), a2, v2, 0, k3);
            PG8_WAIT_V(8); PG8_WAIT_L(0); PG8_BAR; PG8_MMA(1, 0, At, B0); PG8_MMA(1, 1, At, B1); PG8_BAR; PG8_SCHED;
            }
            if constexpr (GA) { if (last) {
#pragma unroll
                for (int h = 0; h < 2; ++h)
#pragma unroll
                    for (int i = 0; i < 2; ++i) cvo[h][i] = v2[h][i]; } }
        }
        if (wr == 0) PG8_BAR;
        { const int l2_ = tid_() & 63; E(acc, cur, wr, wc, l2_ & 15, l2_ >> 4); }
#ifdef MK_EPI2
        E(acc, cur, wr, wc, fr, fq);
#endif
        if (!has_next) break;
        if constexpr (!(Sched::FP8 && !HM)) {
#pragma unroll
        for (int a = 0; a < 2; ++a)
#pragma unroll
            for (int b = 0; b < 2; ++b)
#pragma unroll
                for (int m = 0; m < 4; ++m)
#pragma unroll
                    for (int n = 0; n < 2; ++n) acc[a][b][m][n] = (f32x4){0.f, 0.f, 0.f, 0.f};
        }
        cur = nxt; cB = nB; cA = nA; ++ui;
        if (wr == 1) PG8_BAR;
    }
    PG8_WAIT_V(0);
    PG8_BAR;
#undef PG8_SA
#undef PG8_SB
#undef PG8_STAGE
#undef PG8_STAGE_A
#undef PG8_LDA
#undef PG8_LDB
#undef PG8_MMA
#undef PG8_MMAZ
#undef PG8_WAIT_V
#undef PG8_WAIT_L
#undef PG8_BAR
#undef PG8_SCHED
}

#define EPI_LOOP_BEGIN \
    _Pragma("unroll") for (int bj = 0; bj < 2; ++bj) { const int c0 = u.col0 + bj * HALF + wc * 32 + 8 * fq; (void)c0;
#define EPI_ROWS_BEGIN \
    _Pragma("unroll") for (int ai = 0; ai < NAI; ++ai) _Pragma("unroll") for (int m = 0; m < 4; ++m) { const int lr = ai * HALF + wr * 64 + m * 16 + fr; const int row = u.row0 + lr; (void)row; \
        float v[8]; { const f32x4 v0 = acc[ai][bj][m][0], v1 = acc[ai][bj][m][1]; v[0] = v0[0]; v[1] = v0[1]; v[2] = v0[2]; v[3] = v0[3]; v[4] = v1[0]; v[5] = v1[1]; v[6] = v1[2]; v[7] = v1[3]; }
#define EPI_END } }

template <bool HM_ = false> struct EpiBf16 {
    static constexpr int NAI = HM_ ? 1 : 2;
    bf16_t* O; int ld, ncols; float sc;
    DI void operator()(const f32x4 (&acc)[2][2][4][2], const Unit& u, int wr, int wc, int fr, int fq) const {
        EPI_LOOP_BEGIN
            if (c0 < ncols) {
        EPI_ROWS_BEGIN
                u32x4 w; w.x = pk(v[0] * sc, v[1] * sc); w.y = pk(v[2] * sc, v[3] * sc); w.z = pk(v[4] * sc, v[5] * sc); w.w = pk(v[6] * sc, v[7] * sc);
                *(u32x4*)(O + (size_t)row * ld + c0) = w;
            } }
        }
    }
};
struct EpiF32 {
    static constexpr int NAI = 2;
    float* O; int ld, ncols;
    DI void operator()(const f32x4 (&acc)[2][2][4][2], const Unit& u, int wr, int wc, int fr, int fq) const {
        EPI_LOOP_BEGIN
            if (c0 < ncols) {
        EPI_ROWS_BEGIN
                float* p = O + (size_t)row * ld + c0;
                *(f32x4*)p = (f32x4){v[0], v[1], v[2], v[3]}; *(f32x4*)(p + 4) = (f32x4){v[4], v[5], v[6], v[7]};
            } }
        }
    }
};
struct EpiHgIn {
    static constexpr int NAI = 2;
    bf16_t* P; const float* lb; float sc;
    DI void operator()(const f32x4 (&acc)[2][2][4][2], const Unit& u, int wr, int wc, int fr, int fq) const {
        const int sec = u.col0 >> 11;
        EPI_LOOP_BEGIN
            float lbv[8];
#pragma unroll
            for (int j = 0; j < 8; ++j) lbv[j] = 0.f;
            if (sec == 1 || sec == 2) { const float* lp = lb + (sec - 1) * 2048 + (c0 & 2047); const f32x4 l0 = *(const f32x4*)lp, l1 = *(const f32x4*)(lp + 4);
                lbv[0] = l0[0]; lbv[1] = l0[1]; lbv[2] = l0[2]; lbv[3] = l0[3]; lbv[4] = l1[0]; lbv[5] = l1[1]; lbv[6] = l1[2]; lbv[7] = l1[3]; }
        EPI_ROWS_BEGIN
#pragma unroll
            for (int j = 0; j < 8; ++j) v[j] *= sc;
            if (sec == 0 || sec == 4) {
#pragma unroll
                for (int j = 0; j < 8; ++j) v[j] = v[j] * sigm(v[j]);
            } else if (sec == 1 || sec == 2) {
#pragma unroll
                for (int j = 0; j < 8; ++j) v[j] = __logf(lbv[j] + (1.0f - lbv[j]) * sigm(v[j]));
            }
            u32x4 w; w.x = pk(v[0], v[1]); w.y = pk(v[2], v[3]); w.z = pk(v[4], v[5]); w.w = pk(v[6], v[7]);
            *(u32x4*)(P + (size_t)row * HGN + c0) = w;
        EPI_END
    }
};
template <bool HM_, bool ACT8_ = HM_> struct EpiGU {
    static constexpr int NAI = HM_ ? 1 : 2;
    bf16_t* act; const float* bgu; float sc;
    DI void operator()(const f32x4 (&acc)[2][2][4][2], const Unit& u, int wr, int wc, int fr, int fq) const {
        EPI_LOOP_BEGIN
            const float* bp = bgu + (size_t)u.e * 4096 + c0; const f32x4 b0 = *(const f32x4*)bp, b1 = *(const f32x4*)(bp + 4);
        EPI_ROWS_BEGIN
            const float x0 = fminf(v[0] * sc + b0[0], 7.f), l0 = fminf(fmaxf(v[1] * sc + b0[1], -7.f), 7.f);
            const float x1 = fminf(v[2] * sc + b0[2], 7.f), l1 = fminf(fmaxf(v[3] * sc + b0[3], -7.f), 7.f);
            const float x2 = fminf(v[4] * sc + b1[0], 7.f), l2 = fminf(fmaxf(v[5] * sc + b1[1], -7.f), 7.f);
            const float x3 = fminf(v[6] * sc + b1[2], 7.f), l3 = fminf(fmaxf(v[7] * sc + b1[3], -7.f), 7.f);
            const float a0 = x0 * sigm(1.702f * x0) * (l0 + 1.f), a1 = x1 * sigm(1.702f * x1) * (l1 + 1.f);
            const float a2 = x2 * sigm(1.702f * x2) * (l2 + 1.f), a3 = x3 * sigm(1.702f * x3) * (l3 + 1.f);
            if constexpr (ACT8_) *(unsigned*)((unsigned char*)act + (size_t)row * 2048 + (c0 >> 1)) = pk8(a0 * F8_ACTSCALE, a1 * F8_ACTSCALE, a2 * F8_ACTSCALE, a3 * F8_ACTSCALE);
            else { u32x2 w; w.x = pk(a0, a1); w.y = pk(a2, a3); *(u32x2*)(act + (size_t)row * 2048 + (c0 >> 1)) = w; }
        EPI_END
    }
};
template <bool HM_> struct EpiDN {
    static constexpr int NAI = HM_ ? 1 : 2;
    bf16_t* y2; const float* bdn; const float* lgate; const LAS int* cn; float sc;
    DI void operator()(const f32x4 (&acc)[2][2][4][2], const Unit& u, int wr, int wc, int fr, int fq) const {
        const int cnt = cn[u.e];
        EPI_LOOP_BEGIN
            const float* bp = bdn + (size_t)u.e * 2048 + c0; const f32x4 b0 = *(const f32x4*)bp, b1 = *(const f32x4*)(bp + 4);
        EPI_ROWS_BEGIN
            const int slot = u.aux + lr;
            const float g = slot < cnt ? lgate[(size_t)u.e * TCAP + slot] : 0.f;
            u32x4 w; w.x = pk((v[0] * sc + b0[0]) * g, (v[1] * sc + b0[1]) * g); w.y = pk((v[2] * sc + b0[2]) * g, (v[3] * sc + b0[3]) * g);
            w.z = pk((v[4] * sc + b1[0]) * g, (v[5] * sc + b1[1]) * g); w.w = pk((v[6] * sc + b1[2]) * g, (v[7] * sc + b1[3]) * g);
            *(u32x4*)(y2 + (size_t)row * 2048 + c0) = w;
        EPI_END
    }
};
}

struct Args { const float* in[24]; float* out; unsigned char* ws; int ph_lo, ph_hi; };
enum { I_X = 0, I_C, I_CTX, I_CCTX, I_ADAW, I_ADAB, I_LNG, I_LNB, I_HGWIN, I_HGGN, I_HGLB, I_HGWO, I_MWIN, I_MQN, I_MKVN, I_MWUQ, I_MWUKV, I_MWO, I_RW, I_RB, I_WGU, I_BGU, I_WDN, I_BDN };

namespace cvq {
constexpr int E0 = 1280, E1 = 1536, E2 = 17920, E3 = 26112, E4 = 26256, E5 = 26352, E6 = 26480, E7 = 26736, E8 = 43120, TOTAL = 51312, BATCH = 8;
constexpr int CV_NEXT = 8192, CV_DONE0 = 8256;
DI int need(int p) { return p < 2 ? 0 : p < 5 ? E0 : p < 7 ? E1 : p < 8 ? E2 : p < 10 ? E3 : p < 12 ? E4 : p < 14 ? E6 : p < 16 ? E7 : p < 17 ? E8 : TOTAL; }
struct Tile { const float* sp; bf16_t* dp; int K, N, ncol0, f8; };
DI void decode(const Args& a, int t, Tile& x) {
    unsigned char* ws = a.ws;
    const float* src; bf16_t* dst; int K, N, nmat_per; size_t ss, ds; int loc; int f8 = 0;
    if (t < E0)      { src = a.in[I_HGWIN]; dst = (bf16_t*)(ws + WS_WHGIN); K = 2048; N = HGN;  ss = 0; ds = 0; loc = t; f8 = 1; }
    else if (t < E1) { src = a.in[I_HGWO];  dst = (bf16_t*)(ws + WS_WHGO);  K = 2048; N = 2048; ss = 0; ds = 0; loc = t - E0; f8 = 2; }
    else if (t < E2) { src = a.in[I_WGU];   dst = (bf16_t*)(ws + WS_WGU);   K = 2048; N = 4096; ss = (size_t)2048 * 4096; ds = ss; loc = t - E1; f8 = 1; }
    else if (t < E3) { src = a.in[I_WDN];   dst = (bf16_t*)(ws + WS_WDN);   K = 2048; N = 2048; ss = (size_t)2048 * 2048; ds = ss; loc = t - E2; f8 = 2; }
    else if (t < E4) { src = a.in[I_MWIN];  dst = (bf16_t*)(ws + WS_WMIN);  K = 2048; N = 1088; ss = 0; ds = 0; loc = t - E3; }
    else if (t < E5) { src = a.in[I_MWUQ];  dst = (bf16_t*)(ws + WS_WUQ);   K = 512;  N = 3072; ss = 0; ds = 0; loc = t - E4; }
    else if (t < E6) { src = a.in[I_MWUKV]; dst = (bf16_t*)(ws + WS_WUKV);  K = 512;  N = 4096; ss = 0; ds = 0; loc = t - E5; }
    else if (t < E7) { src = a.in[I_MWO];   dst = (bf16_t*)(ws + WS_WMO);   K = 2048; N = 2048; ss = 0; ds = 0; loc = t - E6; f8 = 2; }
    else if (t < E8) { src = a.in[I_WGU] + (size_t)32 * 2048 * 4096; dst = (bf16_t*)(ws + WS_WGU) + (size_t)32 * 2048 * 4096; K = 2048; N = 4096; ss = (size_t)2048 * 4096; ds = ss; loc = t - E7; f8 = 1; }
    else             { src = a.in[I_WDN] + (size_t)32 * 2048 * 2048; dst = (bf16_t*)(ws + WS_WDN) + (size_t)32 * 2048 * 2048; K = 2048; N = 2048; ss = (size_t)2048 * 2048; ds = ss; loc = t - E8; f8 = 2; }
    (void)nmat_per;
    const int ntiles = (N + 127) / 128, ktiles = K / 128, per = ktiles * ntiles, mat = loc / per, rem = loc - mat * per, ntl = rem / ktiles, kt = rem - ntl * ktiles;
    x.K = K; x.N = N; x.ncol0 = ntl * 128;
    x.sp = src + (size_t)mat * ss + (size_t)(kt * 128) * N + ntl * 128;
    x.dp = dst + (size_t)mat * ds + (size_t)(ntl * 128) * K + kt * 128; x.f8 = f8;
    if (f8) x.dp = (bf16_t*)((unsigned char*)dst + (size_t)mat * ds + (size_t)(ntl * 128) * K + kt * 128);
}
DI void load_tile(const Tile& x, int n4, int kr, f32x4 (&rg)[8]) {
    int nc = n4 * 4; { const int lim = x.N - x.ncol0 - 4; nc = nc < lim ? nc : lim; }
    const float* sp = x.sp + (size_t)kr * x.N + nc;
#pragma unroll
    for (int i = 0; i < 8; ++i) rg[i] = __builtin_nontemporal_load((const f32x4*)(sp + (size_t)(16 * i) * x.N));
}
DI void out_tile(const Tile& cur, LAS float* tile, int k8, int ng) {
    f32x4 v[8];
#pragma unroll
    for (int i = 0; i < 8; ++i) v[i] = *(const LAS f32x4*)(tile + (8 * k8 + i) * 128 + 4 * (ng ^ k8));
    if (cur.f8) {
        unsigned char* dp = (unsigned char*)cur.dp + (size_t)(4 * ng) * cur.K + 8 * k8; const float ws_ = cur.f8 == 1 ? F8_WSCALE : F8_WSCALE_DN;
#pragma unroll
        for (int j = 0; j < 4; ++j) {
            u32x2 w; w.x = pk8(v[0][j] * ws_, v[1][j] * ws_, v[2][j] * ws_, v[3][j] * ws_); w.y = pk8(v[4][j] * ws_, v[5][j] * ws_, v[6][j] * ws_, v[7][j] * ws_);
            __builtin_nontemporal_store(w, (u32x2*)(dp + (size_t)j * cur.K));
        }
    } else if (cur.ncol0 + 4 * ng < cur.N) {
        bf16_t* dp = cur.dp + (size_t)(4 * ng) * cur.K + 8 * k8;
#pragma unroll
        for (int j = 0; j < 4; ++j) {
            u32x4 w; w.x = pk(v[0][j], v[1][j]); w.y = pk(v[2][j], v[3][j]); w.z = pk(v[4][j], v[5][j]); w.w = pk(v[6][j], v[7][j]);
            __builtin_nontemporal_store(w, (u32x4*)(dp + (size_t)j * cur.K));
        }
    }
}
DI void batch(const Args& a, int t0, LAS unsigned char* lds) {
    constexpr int nb = BATCH;
    LAS float* tile = (LAS float*)lds;
    const int tid = tid_(), n4 = tid & 31, kr = tid >> 5, k8 = tid & 15, ng = tid >> 4;
    f32x4 rgA[8], rgB[8]; Tile tA, tB, tn;
    decode(a, t0, tA); load_tile(tA, n4, kr, rgA);
    decode(a, t0 + 1, tB); load_tile(tB, n4, kr, rgB);
#define CV_PUT(RG) _Pragma("unroll") for (int i = 0; i < 8; ++i) *(LAS f32x4*)(tile + (kr + 16 * i) * 128 + 4 * (n4 ^ (((kr >> 3) + 2 * i) & 15))) = RG[i]
#pragma unroll
    for (int j = 0; j < nb; j += 2) {
        CV_PUT(rgA);
        __syncthreads();
        if (j + 2 < nb) { decode(a, t0 + j + 2, tn); load_tile(tn, n4, kr, rgA); }
        out_tile(tA, tile, k8, ng);
        __syncthreads();
        tA = tn;
        CV_PUT(rgB);
        __syncthreads();
        if (j + 3 < nb) { decode(a, t0 + j + 3, tn); load_tile(tn, n4, kr, rgB); }
        out_tile(tB, tile, k8, ng);
        __syncthreads();
        tB = tn;
    }
#undef CV_PUT
}
DI void service(const Args& a, LAS unsigned char* lds, int mandatory, unsigned* done_word, unsigned done_target) {
    unsigned* nextw = (unsigned*)(a.ws + WS_CTL) + CV_NEXT;
    volatile LAS int* slot = (volatile LAS int*)(lds + LCTL_OFF + 512);
    for (;;) {
        __syncthreads();
        if (threadIdx.x == 0) {
            int t0 = -1; const unsigned curv = __hip_atomic_load(nextw, __ATOMIC_RELAXED, __HIP_MEMORY_SCOPE_AGENT);
            bool go = curv < (unsigned)TOTAL && (curv < (unsigned)mandatory || (done_word != nullptr && __hip_atomic_load(done_word, __ATOMIC_RELAXED, __HIP_MEMORY_SCOPE_AGENT) < done_target));
            if (go) { t0 = (int)__hip_atomic_fetch_add(nextw, (unsigned)BATCH, __ATOMIC_RELAXED, __HIP_MEMORY_SCOPE_AGENT); if (t0 >= TOTAL) t0 = -1; }
            slot[0] = t0;
        }
        __syncthreads();
        const int t0 = slot[0];
        if (t0 < 0) break;
        batch(a, t0, lds);
    }
}
DI void signal_done(const Args& a, int p) {
    asm volatile("s_waitcnt vmcnt(0)" ::: "memory"); __syncthreads();
    if (threadIdx.x == 0) __hip_atomic_fetch_add((unsigned*)(a.ws + WS_CTL) + CV_DONE0 + 64 * p, 1u, __ATOMIC_RELAXED, __HIP_MEMORY_SCOPE_AGENT);
}
DI unsigned* done_word(const Args& a, int p) { return (unsigned*)(a.ws + WS_CTL) + CV_DONE0 + 64 * p; }
}

DI void p0_prologue(const Args& a, LAS unsigned char* lds, int G) {
    const int tid = tid_();
    unsigned char* ws = a.ws;
    if ((int)blockIdx.x < 192) {
        LAS float* sc = (LAS float*)lds;
        LAS float* red = (LAS float*)(lds + 40960);
        for (int idx = tid; idx < 5 * 2048; idx += 512) { const int r = idx >> 11, k = idx & 2047; const float v = r < 4 ? a.in[I_C][r * 2048 + k] : a.in[I_CCTX][k]; sc[idx] = v * sigm(v); }
        __syncthreads();
        float* modv = (float*)(ws + WS_MODV);
        for (int u = blockIdx.x; u < 192; u += G) {
            const int l = u / 96, n0 = (u % 96) * 128, cg = tid & 31, kq = tid >> 5;
            f32x4 ac[5];
#pragma unroll
            for (int r = 0; r < 5; ++r) ac[r] = (f32x4){0.f, 0.f, 0.f, 0.f};
            const float* wp = a.in[I_ADAW] + ((size_t)l * 2048 + kq * 128) * NMOD + n0 + cg * 4;
#pragma unroll 8
            for (int kk = 0; kk < 128; ++kk) {
                const f32x4 w = *(const f32x4*)(wp + (size_t)kk * NMOD);
#pragma unroll
                for (int r = 0; r < 5; ++r) { const float s = sc[r * 2048 + kq * 128 + kk]; ac[r] += s * w; }
            }
#pragma unroll
            for (int r = 0; r < 5; ++r) *(LAS f32x4*)(red + (kq * 5 + r) * 128 + cg * 4) = ac[r];
            __syncthreads();
            for (int idx = tid; idx < 640; idx += 512) { const int r = idx >> 7, n = idx & 127; float s = a.in[I_ADAB][l * NMOD + n0 + n];
                for (int q = 0; q < 16; ++q) s += red[(q * 5 + r) * 128 + n];
                modv[((size_t)l * 5 + r) * NMOD + n0 + n] = s; }
            __syncthreads();
        }
    }
    if ((int)blockIdx.x == G - 1) {
        float* lb = (float*)(ws + WS_LB); float* cs = (float*)(ws + WS_ROPE);
        for (int idx = tid; idx < 4096; idx += 512) {
            const float l0 = a.in[I_HGLB][idx], l1 = a.in[I_HGLB][4096 + idx], l2 = a.in[I_HGLB][8192 + idx];
            const float mx = fmaxf(l0, fmaxf(l1, l2)); const float e0 = expf(l0 - mx), e1 = expf(l1 - mx), e2 = expf(l2 - mx);
            lb[idx] = e0 / (e0 + e1 + e2);
        }
        for (int idx = tid; idx < 1024; idx += 512) { const int pos = idx >> 4, i = idx & 15; const float fr = powf(10000.0f, -(float)i / 16.0f); const float ang = (float)pos * fr;
            cs[idx * 2] = cosf(ang); cs[idx * 2 + 1] = sinf(ang); }
    }
    __syncthreads();
}

DI void ph_modulate(const float* xl, const float* xc, const float* modl  , int jshift, int jscale, bf16_t* hout, int G) {
    const int tid = tid_(); const int lane = tid & 63, wv = __builtin_amdgcn_readfirstlane(tid >> 6);
    for (int row = blockIdx.x * 8 + wv; row < T; row += G * 8) {
        const float* xp = row < TL ? xl + (size_t)row * DM : xc + (size_t)(row - TL) * DM;
        const float* mp = modl + (size_t)(row < TL ? (row >> 12) : 4) * NMOD;
        f32x4 x[8]; float s = 0.f;
#pragma unroll
        for (int i = 0; i < 8; ++i) { x[i] = *(const f32x4*)(xp + (i * 64 + lane) * 4); s += (x[i][0] + x[i][1]) + (x[i][2] + x[i][3]); }
        const float mean = wave_sum(s) * (1.0f / DM); float q = 0.f;
#pragma unroll
        for (int i = 0; i < 8; ++i) { const f32x4 d = x[i] - mean; q += (d[0] * d[0] + d[1] * d[1]) + (d[2] * d[2] + d[3] * d[3]); }
        const float rstd = rsqrtf(wave_sum(q) * (1.0f / DM) + LN_EPS);
#pragma unroll
        for (int i = 0; i < 8; ++i) { const int d0 = (i * 64 + lane) * 4; const f32x4 sh = *(const f32x4*)(mp + jshift * DM + d0), sc = *(const f32x4*)(mp + jscale * DM + d0);
            const f32x4 hv = (x[i] - mean) * rstd * (1.0f + sc) + sh;
            *(unsigned*)((unsigned char*)hout + (size_t)row * DM + d0) = pk8(clamp8(hv[0] * F8_ASCALE), clamp8(hv[1] * F8_ASCALE), clamp8(hv[2] * F8_ASCALE), clamp8(hv[3] * F8_ASCALE)); }
    }
}

DI void ph_hg_combine(const Args& a, int G) {
    const bf16_t* of = (const bf16_t*)(a.ws + WS_OF); const bf16_t* ob = (const bf16_t*)(a.ws + WS_OB); const bf16_t* P = (const bf16_t*)(a.ws + WS_P);
    bf16_t* og = (bf16_t*)(a.ws + WS_OG); const float* gn = a.in[I_HGGN];
    const int tid = tid_(); const int lane = tid & 63, wv = __builtin_amdgcn_readfirstlane(tid >> 6);
    for (int row = blockIdx.x * 8 + wv; row < T; row += G * 8) {
        float o[32]; float ss = 0.f;
#pragma unroll
        for (int q = 0; q < 4; ++q) { const u32x4 f = *(const u32x4*)(of + (size_t)row * DM + lane * 32 + q * 8), b = *(const u32x4*)(ob + (size_t)row * DM + lane * 32 + q * 8);
#pragma unroll
            for (int j = 0; j < 4; ++j) { o[q * 8 + 2 * j] = bf_lo(f[j]) + bf_lo(b[j]); o[q * 8 + 2 * j + 1] = bf_hi(f[j]) + bf_hi(b[j]); } }
#pragma unroll
        for (int j = 0; j < 32; ++j) ss += o[j] * o[j];
        ss += __shfl_xor(ss, 1); ss += __shfl_xor(ss, 2);
        const float r = rsqrtf(ss * (1.0f / 128.0f) + RMS_EPS);
#pragma unroll
        for (int q = 0; q < 4; ++q) { const u32x4 g = *(const u32x4*)(P + (size_t)row * HGN + 8192 + lane * 32 + q * 8);
            const f32x4 w0 = *(const f32x4*)(gn + lane * 32 + q * 8), w1 = *(const f32x4*)(gn + lane * 32 + q * 8 + 4);
            float t[8];
#pragma unroll
            for (int j = 0; j < 4; ++j) { t[2 * j] = o[q * 8 + 2 * j] * r * (j < 2 ? w0[2 * j] : w1[2 * j - 4]) * bf_lo(g[j]); t[2 * j + 1] = o[q * 8 + 2 * j + 1] * r * (j < 2 ? w0[2 * j + 1] : w1[2 * j - 3]) * bf_hi(g[j]); }
#pragma unroll
            for (int j = 0; j < 8; ++j) t[j] = clamp8(t[j] * F8_OGSCALE);
            u32x2 w; w.x = pk8(t[0], t[1], t[2], t[3]); w.y = pk8(t[4], t[5], t[6], t[7]);
            *(u32x2*)((unsigned char*)og + (size_t)row * DM + lane * 32 + q * 8) = w; }
    }
}

DI void ph_post_router(const Args& a, int layer, const float* xl, const float* xc, const bf16_t* y, int nrows, LAS unsigned char* lds, int G) {
    unsigned char* ws = a.ws;
    const int tid = tid_(), lane = tid & 63, wv = __builtin_amdgcn_readfirstlane(tid >> 6);
    const float* modl = (const float*)(ws + WS_MODV) + (size_t)layer * 5 * NMOD;
    const float* lng = a.in[I_LNG] + (size_t)(layer * 2 + 0) * DM; const float* lnb = a.in[I_LNB] + (size_t)(layer * 2 + 0) * DM;
    const float* rw = a.in[I_RW] + (size_t)layer * DM * NE; const float* rb = a.in[I_RB] + layer * NE;
    float* x1 = (float*)(ws + WS_X1); bf16_t* h2 = (bf16_t*)(ws + WS_H2);
    unsigned* cnt = (unsigned*)(ws + (layer ? CTL_CNT1 : CTL_CNT0));
    int* ltok = (int*)(ws + WS_LTOK); float* lgate = (float*)(ws + WS_LGATE); unsigned* tokes = (unsigned*)(ws + WS_TOKES);
    LAS float* hs = (LAS float*)lds;
    LAS int* asg_e = (LAS int*)(lds + TAB_OFF); LAS float* asg_g = (LAS float*)(lds + TAB_OFF + 2048); LAS int* asg_s = (LAS int*)(lds + TAB_OFF + 4096);
    LAS int* lc = (LAS int*)(lds + TAB_OFF + 6144); LAS int* lbase = (LAS int*)(lds + TAB_OFF + 6400);
    const int rpb = nrows / G, row0 = blockIdx.x * rpb;
    if (tid < 32) lc[tid] = 0;
    __syncthreads();
    for (int g0 = 0; g0 < rpb; g0 += 16) {
#pragma unroll 1
        for (int rr = 0; rr < 2; ++rr) {
            const int lr = wv * 2 + rr, ri = g0 + lr;
            if (ri < rpb) {
                const int row = row0 + ri;
                const float* xp = row < TL ? xl + (size_t)row * DM : xc + (size_t)(row - TL) * DM;
                const float* mp = modl + (size_t)(row < TL ? (row >> 12) : 4) * NMOD;
                f32x4 z[8]; float s = 0.f;
#pragma unroll
                for (int i = 0; i < 8; ++i) { const int d0 = (i * 64 + lane) * 4; const f32x4 xv = *(const f32x4*)(xp + d0); const u32x2 yv = *(const u32x2*)(y + (size_t)row * DM + d0);
                    const f32x4 gt = *(const f32x4*)(mp + 2 * DM + d0); const f32x4 yf = {bf_lo(yv.x), bf_hi(yv.x), bf_lo(yv.y), bf_hi(yv.y)};
                    z[i] = DN_ALPHA * xv + gt * yf; s += (z[i][0] + z[i][1]) + (z[i][2] + z[i][3]); }
                float mean = wave_sum(s) * (1.0f / DM), q = 0.f;
#pragma unroll
                for (int i = 0; i < 8; ++i) { const f32x4 d = z[i] - mean; q += (d[0] * d[0] + d[1] * d[1]) + (d[2] * d[2] + d[3] * d[3]); }
                float rstd = rsqrtf(wave_sum(q) * (1.0f / DM) + LN_EPS);
                s = 0.f;
#pragma unroll
                for (int i = 0; i < 8; ++i) { const int d0 = (i * 64 + lane) * 4; const f32x4 gg = *(const f32x4*)(lng + d0), bb = *(const f32x4*)(lnb + d0);
                    z[i] = (z[i] - mean) * rstd * gg + bb; *(f32x4*)(x1 + (size_t)row * DM + d0) = z[i]; s += (z[i][0] + z[i][1]) + (z[i][2] + z[i][3]); }
                mean = wave_sum(s) * (1.0f / DM); q = 0.f;
#pragma unroll
                for (int i = 0; i < 8; ++i) { const f32x4 d = z[i] - mean; q += (d[0] * d[0] + d[1] * d[1]) + (d[2] * d[2] + d[3] * d[3]); }
                rstd = rsqrtf(wave_sum(q) * (1.0f / DM) + LN_EPS);
#pragma unroll
                for (int i = 0; i < 8; ++i) { const int d0 = (i * 64 + lane) * 4; const f32x4 sh = *(const f32x4*)(mp + 3 * DM + d0), sc = *(const f32x4*)(mp + 4 * DM + d0);
                    const f32x4 hv = (z[i] - mean) * rstd * (1.0f + sc) + sh; u32x2 w; w.x = pk(hv[0], hv[1]); w.y = pk(hv[2], hv[3]);
                    if (true) *(unsigned*)((unsigned char*)h2 + (size_t)row * DM + d0) = pk8(clamp8(hv[0] * F8_ASCALE), clamp8(hv[1] * F8_ASCALE), clamp8(hv[2] * F8_ASCALE), clamp8(hv[3] * F8_ASCALE));
                    else *(u32x2*)(h2 + (size_t)row * DM + d0) = w;
                    *(LAS f32x4*)(hs + lr * DM + d0) = hv; }
            }
        }
        __syncthreads();
        {
            LAS float* red = (LAS float*)(lds + TAB_OFF + 8192);
            {
                const int e = tid & 31, rg = (tid >> 5) & 3, dq = tid >> 7;
                float ac[4] = {0.f, 0.f, 0.f, 0.f};
                const LAS float* hp = hs + (4 * rg) * DM + dq * 512; const float* wp = rw + (size_t)(dq * 512) * NE + e;
#pragma unroll 2
                for (int d = 0; d < 512; d += 4) {
                    const float w0 = wp[(d + 0) * NE], w1 = wp[(d + 1) * NE], w2 = wp[(d + 2) * NE], w3 = wp[(d + 3) * NE];
#pragma unroll
                    for (int r = 0; r < 4; ++r) { const f32x4 hv = *(const LAS f32x4*)(hp + r * DM + d); ac[r] += (hv[0] * w0 + hv[1] * w1) + (hv[2] * w2 + hv[3] * w3); }
                }
#pragma unroll
                for (int r = 0; r < 4; ++r) red[(dq * 16 + 4 * rg + r) * 32 + e] = ac[r];
            }
            __syncthreads();
            const int lr = tid >> 5, e = tid & 31, ri = g0 + lr;
            float val = (red[lr * 32 + e] + red[(16 + lr) * 32 + e]) + (red[(32 + lr) * 32 + e] + red[(48 + lr) * 32 + e]) + rb[e];
            float tv[4]; int te[4];
#pragma unroll
            for (int k = 0; k < 4; ++k) {
                float m = val;
#pragma unroll
                for (int o = 16; o >= 1; o >>= 1) m = fmaxf(m, __shfl_xor(m, o));
                int idx = (val == m) ? e : 99;
#pragma unroll
                for (int o = 16; o >= 1; o >>= 1) idx = min(idx, __shfl_xor(idx, o));
                tv[k] = m; te[k] = idx; if (e == idx) val = -3.0e38f;
            }
            if (e == 0 && ri < rpb) {
                const float e1 = __expf(tv[1] - tv[0]), e2 = __expf(tv[2] - tv[0]), e3 = __expf(tv[3] - tv[0]); const float inv = 1.0f / (1.0f + e1 + e2 + e3);
                const float gk[4] = {inv, e1 * inv, e2 * inv, e3 * inv};
#pragma unroll
                for (int k = 0; k < 4; ++k) { const int ai = ri * 4 + k; asg_e[ai] = te[k]; asg_g[ai] = gk[k]; asg_s[ai] = atomicAdd((int*)(lc + te[k]), 1); }
            }
        }
        __syncthreads();
    }
    if (tid < 32) lbase[tid] = (int)__hip_atomic_fetch_add(cnt + tid * 64, (unsigned)lc[tid], __ATOMIC_RELAXED, __HIP_MEMORY_SCOPE_AGENT);
    __syncthreads();
    for (int ai = tid; ai < rpb * 4; ai += 512) {
        const int row = row0 + (ai >> 2), e = asg_e[ai], slot = lbase[e] + asg_s[ai];
        ltok[(size_t)e * TCAP + slot] = row; lgate[(size_t)e * TCAP + slot] = asg_g[ai]; tokes[(size_t)row * 4 + (ai & 3)] = ((unsigned)slot << 5) | (unsigned)e;
    }
    __syncthreads();
}

DI void moe_setup(const Args& a, int layer, LAS unsigned char* lds) {
    LAS int* tb = (LAS int*)(lds + LCTL_OFF + 64); LAS int* cn = (LAS int*)(lds + LCTL_OFF + 256);
    unsigned* cnt = (unsigned*)(a.ws + (layer ? CTL_CNT1 : CTL_CNT0));
    __syncthreads();
    if (threadIdx.x < 32) cn[threadIdx.x] = (int)__hip_atomic_load(cnt + threadIdx.x * 64, __ATOMIC_RELAXED, __HIP_MEMORY_SCOPE_AGENT);
    __syncthreads();
    if (threadIdx.x == 0) { int s = 0; for (int e = 0; e < 32; ++e) { tb[e] = s; s += (cn[e] + 255) >> 8; } tb[32] = s; }
    if (threadIdx.x == 64) { LAS int* th = (LAS int*)(lds + LCTL_OFF + 640); int s = 0; for (int e = 0; e < 32; ++e) { th[e] = s; s += (cn[e] + 127) >> 7; } th[32] = s; }
    __syncthreads();
}

DI void ph_post_ffn(const Args& a, int layer, int nrows, float* outp, bool next_mod, LAS unsigned char* lds, int G) {
    unsigned char* ws = a.ws;
    moe_setup(a, layer, lds);
    const LAS int* tb = (const LAS int*)(lds + LCTL_OFF + 64);
    const int tid = tid_(); const int lane = tid & 63, wv = __builtin_amdgcn_readfirstlane(tid >> 6);
    const float* modl = (const float*)(ws + WS_MODV) + (size_t)layer * 5 * NMOD;
    const float* modn = (const float*)(ws + WS_MODV) + (size_t)(layer + 1) * 5 * NMOD;
    const float* lng = a.in[I_LNG] + (size_t)(layer * 2 + 1) * DM; const float* lnb = a.in[I_LNB] + (size_t)(layer * 2 + 1) * DM;
    const float* x1 = (const float*)(ws + WS_X1); const bf16_t* y2 = (const bf16_t*)(ws + WS_Y2); const unsigned* tokes = (const unsigned*)(ws + WS_TOKES);
    bf16_t* hn = (bf16_t*)(ws + WS_H);
    for (int row = blockIdx.x * 8 + wv; row < nrows; row += G * 8) {
        const int rsel = row < TL ? (row >> 12) : 4;
        const float* mp = modl + (size_t)rsel * NMOD;
        size_t pr[4];
#pragma unroll
        for (int k = 0; k < 4; ++k) { const unsigned es = tokes[(size_t)row * 4 + k]; const int e = es & 31, slot = es >> 5; pr[k] = ((size_t)tb[e] * 256 + slot) * DM; }
        f32x4 z[8]; float s = 0.f;
#pragma unroll
        for (int i = 0; i < 8; ++i) { const int d0 = (i * 64 + lane) * 4; f32x4 ys = {0.f, 0.f, 0.f, 0.f};
#pragma unroll
            for (int k = 0; k < 4; ++k) { const u32x2 yv = __builtin_nontemporal_load((const u32x2*)(y2 + pr[k] + d0)); ys += (f32x4){bf_lo(yv.x), bf_hi(yv.x), bf_lo(yv.y), bf_hi(yv.y)}; }
            const f32x4 xv = __builtin_nontemporal_load((const f32x4*)(x1 + (size_t)row * DM + d0)), gt = *(const f32x4*)(mp + 5 * DM + d0);
            z[i] = DN_ALPHA * xv + gt * ys; s += (z[i][0] + z[i][1]) + (z[i][2] + z[i][3]); }
        float mean = wave_sum(s) * (1.0f / DM), q = 0.f;
#pragma unroll
        for (int i = 0; i < 8; ++i) { const f32x4 d = z[i] - mean; q += (d[0] * d[0] + d[1] * d[1]) + (d[2] * d[2] + d[3] * d[3]); }
        float rstd = rsqrtf(wave_sum(q) * (1.0f / DM) + LN_EPS);
        s = 0.f;
#pragma unroll
        for (int i = 0; i < 8; ++i) { const int d0 = (i * 64 + lane) * 4; const f32x4 gg = *(const f32x4*)(lng + d0), bb = *(const f32x4*)(lnb + d0);
            z[i] = (z[i] - mean) * rstd * gg + bb; __builtin_nontemporal_store(z[i], (f32x4*)(outp + (size_t)row * DM + d0)); s += (z[i][0] + z[i][1]) + (z[i][2] + z[i][3]); }
        if (next_mod) {
            const float* mq = modn + (size_t)rsel * NMOD;
            mean = wave_sum(s) * (1.0f / DM); q = 0.f;
#pragma unroll
            for (int i = 0; i < 8; ++i) { const f32x4 d = z[i] - mean; q += (d[0] * d[0] + d[1] * d[1]) + (d[2] * d[2] + d[3] * d[3]); }
            rstd = rsqrtf(wave_sum(q) * (1.0f / DM) + LN_EPS);
#pragma unroll
            for (int i = 0; i < 8; ++i) { const int d0 = (i * 64 + lane) * 4; const f32x4 sh = *(const f32x4*)(mq + 0 * DM + d0), sc = *(const f32x4*)(mq + 1 * DM + d0);
                const f32x4 hv = (z[i] - mean) * rstd * (1.0f + sc) + sh; u32x2 w; w.x = pk(hv[0], hv[1]); w.y = pk(hv[2], hv[3]);
                *(u32x2*)(hn + (size_t)row * DM + d0) = w; }
        }
    }
}

DI void ph_mla_local(const Args& a, int G) {
    unsigned char* ws = a.ws;
    const float* pm = (const float*)(ws + WS_PM); bf16_t* cqn = (bf16_t*)(ws + WS_CQN); bf16_t* ckvn = (bf16_t*)(ws + WS_CKVN); bf16_t* kp = (bf16_t*)(ws + WS_KP);
    const float* cs = (const float*)(ws + WS_ROPE); const float* qw = a.in[I_MQN]; const float* kw = a.in[I_MKVN];
    const int tid = tid_(); const int lane = tid & 63, wv = __builtin_amdgcn_readfirstlane(tid >> 6);
    for (int row = blockIdx.x * 8 + wv; row < T; row += G * 8) {
        const float* pp = pm + (size_t)row * 1088;
        {   const f32x4 c0 = *(const f32x4*)(pp + 512 + lane * 8), c1 = *(const f32x4*)(pp + 512 + lane * 8 + 4);
            float ss = (c0[0] * c0[0] + c0[1] * c0[1]) + (c0[2] * c0[2] + c0[3] * c0[3]) + (c1[0] * c1[0] + c1[1] * c1[1]) + (c1[2] * c1[2] + c1[3] * c1[3]);
            const float r = rsqrtf(wave_sum(ss) * (1.0f / 512.0f) + RMS_EPS);
            const f32x4 w0 = *(const f32x4*)(kw + lane * 8), w1 = *(const f32x4*)(kw + lane * 8 + 4);
            u32x4 w; w.x = pk(c0[0] * r * w0[0], c0[1] * r * w0[1]); w.y = pk(c0[2] * r * w0[2], c0[3] * r * w0[3]); w.z = pk(c1[0] * r * w1[0], c1[1] * r * w1[1]); w.w = pk(c1[2] * r * w1[2], c1[3] * r * w1[3]);
            *(u32x4*)(ckvn + (size_t)row * 512 + lane * 8) = w; }
        if (row < TL) {
            const f32x4 c0 = *(const f32x4*)(pp + lane * 8), c1 = *(const f32x4*)(pp + lane * 8 + 4);
            float ss = (c0[0] * c0[0] + c0[1] * c0[1]) + (c0[2] * c0[2] + c0[3] * c0[3]) + (c1[0] * c1[0] + c1[1] * c1[1]) + (c1[2] * c1[2] + c1[3] * c1[3]);
            const float r = rsqrtf(wave_sum(ss) * (1.0f / 512.0f) + RMS_EPS);
            const f32x4 w0 = *(const f32x4*)(qw + lane * 8), w1 = *(const f32x4*)(qw + lane * 8 + 4);
            u32x4 w; w.x = pk(c0[0] * r * w0[0], c0[1] * r * w0[1]); w.y = pk(c0[2] * r * w0[2], c0[3] * r * w0[3]); w.z = pk(c1[0] * r * w1[0], c1[1] * r * w1[1]); w.w = pk(c1[2] * r * w1[2], c1[3] * r * w1[3]);
            *(u32x4*)(cqn + (size_t)row * 512 + lane * 8) = w;
        }
        if (lane < 32) {
            const int i = lane & 15, half = lane >> 4;
            const float xa = pp[1024 + 32 * half + i], xb = pp[1024 + 32 * half + 16 + i];
            float oa = xa, ob = xb;
            if (row < TL) { const int s = row & (SEQ - 1); const int pos = half ? (s & 63) : (s >> 6); const float c = cs[(pos * 16 + i) * 2], sn = cs[(pos * 16 + i) * 2 + 1];
                oa = xa * c - xb * sn; ob = xa * sn + xb * c; }
            const unsigned wa = pk(oa, 0.f), wb = pk(ob, 0.f);
            kp[(size_t)row * 64 + 32 * half + i] = (bf16_t)(wa & 0xffffu); kp[(size_t)row * 64 + 32 * half + 16 + i] = (bf16_t)(wb & 0xffffu);
        }
    }
}

namespace hg {
constexpr int QH_OFF = 0, QT_OFF = 8704, KT_OFF = 17408, KHT_OFF = 26112, VT_OFF = 36352, EB_OFF = 46592, BUFB = 47104, NCH = LSEQ / 32, NCHAIN = 128;
DI int crow(int r, int hi) { return (r & 3) + 8 * (r >> 2) + 4 * hi; }
DI int rowof(int b, int dir, int pos) {
    if (pos < LC) return TL + b * LC + (dir ? (LC - 1 - pos) : pos);
    const int s = pos - LC; return b * SEQ + (dir ? (SEQ - 1 - s) : s);
}
DI bf16x8 pack8(const f32x16& x, int s) { u32x4 p; p.x = pk(x[8 * s], x[8 * s + 1]); p.y = pk(x[8 * s + 2], x[8 * s + 3]); p.z = pk(x[8 * s + 4], x[8 * s + 5]); p.w = pk(x[8 * s + 6], x[8 * s + 7]); return __builtin_bit_cast(bf16x8, p); }
#define HG_MFMA(a, b, c) __builtin_amdgcn_mfma_f32_32x32x16_bf16((a), (b), (c), 0, 0, 0)

DI void scan(const Args& a, LAS unsigned char* lds, int nblk) {
    const bf16_t* P = (const bf16_t*)(a.ws + WS_P);
    const int tid = tid_(), lane = tid & 63, wid = __builtin_amdgcn_readfirstlane(tid >> 6), r32 = lane & 31, hi = lane >> 5;
    const int tau = tid & 31, pc = tid >> 5;
    for (int ch = blockIdx.x; ch < NCHAIN; ch += nblk) {
        const int b = ch >> 5, h = (ch >> 1) & 15, dir = ch & 1;
        bf16_t* O = (bf16_t*)(a.ws + (dir ? WS_OB : WS_OF));
        f32x16 S[4];
#pragma unroll
        for (int i = 0; i < 4; ++i)
#pragma unroll
            for (int r = 0; r < 16; ++r) S[i][r] = 0.f;
        u32x4 qv, lv, vv = {0u, 0u, 0u, 0u};
#define HG_LOAD(cc) do { const size_t rb = (size_t)rowof(b, dir, (cc) * 32 + tau) * HGN; \
            qv = *(const u32x4*)(P + rb + h * 128 + pc * 8); lv = *(const u32x4*)(P + rb + 2048 * (1 + dir) + h * 128 + pc * 8); \
            vv = *(const u32x4*)(P + rb + 6144 + h * 128 + pc * 8); } while (0)
        HG_LOAD(0);
        for (int c = 0; c < NCH; ++c) {
            LAS unsigned char* buf = lds + (c & 1) * BUFB;
            {
                float lf[8], qf[8], bc[8];
#pragma unroll
                for (int j = 0; j < 4; ++j) { lf[2 * j] = bf_lo(lv[j]); lf[2 * j + 1] = bf_hi(lv[j]); qf[2 * j] = bf_lo(qv[j]); qf[2 * j + 1] = bf_hi(qv[j]); }
#pragma unroll
                for (int j = 0; j < 8; ++j) { float v = lf[j];
#pragma unroll
                    for (int d = 1; d < 32; d <<= 1) { const float t = __shfl_up(v, d, 32); if (tau >= d) v += t; }
                    bc[j] = v; }
                float qh[8], qt[8], kt[8], kh[8], eb[8];
#pragma unroll
                for (int j = 0; j < 8; ++j) { const float bm = __shfl(bc[j], 15, 32), bl = __shfl(bc[j], 31, 32); const float kk = 1.0f - __expf(lf[j]);
                    qh[j] = qf[j] * __expf(bc[j]); qt[j] = qf[j] * __expf(bc[j] - bm); kt[j] = kk * __expf(bm - bc[j]); kh[j] = kk * __expf(bl - bc[j]); eb[j] = __expf(bl); }
                {   const int i = pc >> 2, hf = (pc & 3) >> 1, sec = pc & 1; const int p1 = 32 * i + 16 * hf + 4 * sec, p2 = p1 + 8;
                    u32x2 w1, w2; w1.x = pk(qh[0], qh[1]); w1.y = pk(qh[2], qh[3]); w2.x = pk(qh[4], qh[5]); w2.y = pk(qh[6], qh[7]);
                    *(LAS u32x2*)(buf + QH_OFF + tau * 272 + p1 * 2) = w1; *(LAS u32x2*)(buf + QH_OFF + tau * 272 + p2 * 2) = w2; }
                {   u32x4 w; w.x = pk(qt[0], qt[1]); w.y = pk(qt[2], qt[3]); w.z = pk(qt[4], qt[5]); w.w = pk(qt[6], qt[7]); *(LAS u32x4*)(buf + QT_OFF + tau * 272 + pc * 16) = w; }
                {   u32x4 w; w.x = pk(kt[0], kt[1]); w.y = pk(kt[2], kt[3]); w.z = pk(kt[4], kt[5]); w.w = pk(kt[6], kt[7]); *(LAS u32x4*)(buf + KT_OFF + tau * 272 + pc * 16) = w; }
#pragma unroll
                for (int j = 0; j < 8; ++j) { const unsigned w = pk(kh[j], 0.f); *(LAS bf16_t*)(buf + KHT_OFF + (8 * pc + j) * 80 + tau * 2) = (bf16_t)(w & 0xffffu); }
                {
#pragma unroll
                    for (int j = 0; j < 4; ++j) { *(LAS bf16_t*)(buf + VT_OFF + (8 * pc + 2 * j) * 80 + tau * 2) = (bf16_t)(vv[j] & 0xffffu); *(LAS bf16_t*)(buf + VT_OFF + (8 * pc + 2 * j + 1) * 80 + tau * 2) = (bf16_t)(vv[j] >> 16); }
                }
                if (tau == 31) {
#pragma unroll
                    for (int j = 0; j < 8; ++j) *(LAS float*)(buf + EB_OFF + (8 * pc + j) * 4) = eb[j];
                }
            }
            if (c + 1 < NCH) HG_LOAD(c + 1);
            __syncthreads();
            if (wid < 4) {
                const int jv = wid;
                f32x16 at;
#pragma unroll
                for (int r = 0; r < 16; ++r) at[r] = 0.f;
#pragma unroll
                for (int kk = 0; kk < 8; ++kk) { const bf16x8 ka = *(const LAS bf16x8*)(buf + KT_OFF + r32 * 272 + (16 * kk + 8 * hi) * 2), qb = *(const LAS bf16x8*)(buf + QT_OFF + r32 * 272 + (16 * kk + 8 * hi) * 2);
                    at = HG_MFMA(ka, qb, at); }
#pragma unroll
                for (int r = 0; r < 16; ++r) at[r] = (crow(r, hi) <= r32) ? at[r] : 0.f;
                const bf16x8 ab0 = pack8(at, 0), ab1 = pack8(at, 1);
                f32x16 ot;
#pragma unroll
                for (int r = 0; r < 16; ++r) ot[r] = 0.f;
                {   const LAS unsigned char* vp = buf + VT_OFF + (32 * jv + r32) * 80;
                    const s16x4 a0 = *(const LAS s16x4*)(vp + (4 * hi) * 2), a1 = *(const LAS s16x4*)(vp + (8 + 4 * hi) * 2), a2 = *(const LAS s16x4*)(vp + (16 + 4 * hi) * 2), a3 = *(const LAS s16x4*)(vp + (24 + 4 * hi) * 2);
                    const bf16x8 va0 = {a0[0], a0[1], a0[2], a0[3], a1[0], a1[1], a1[2], a1[3]}, va1 = {a2[0], a2[1], a2[2], a2[3], a3[0], a3[1], a3[2], a3[3]};
                    ot = HG_MFMA(va0, ab0, ot); ot = HG_MFMA(va1, ab1, ot); }
#pragma unroll
                for (int i = 0; i < 4; ++i) { const bf16x8 sa0 = pack8(S[i], 0), sa1 = pack8(S[i], 1);
                    const bf16x8 q0 = *(const LAS bf16x8*)(buf + QH_OFF + r32 * 272 + (32 * i + 8 * hi) * 2), q1 = *(const LAS bf16x8*)(buf + QH_OFF + r32 * 272 + (32 * i + 16 + 8 * hi) * 2);
                    ot = HG_MFMA(sa0, q0, ot); ot = HG_MFMA(sa1, q1, ot); }
                {   bf16_t* op = O + (size_t)rowof(b, dir, c * 32 + r32) * DM + h * 128 + 32 * jv + 4 * hi;
#pragma unroll
                    for (int g = 0; g < 4; ++g) { u32x2 w; w.x = pk(ot[4 * g], ot[4 * g + 1]); w.y = pk(ot[4 * g + 2], ot[4 * g + 3]); *(u32x2*)(op + 8 * g) = w; } }
#pragma unroll
                for (int i = 0; i < 4; ++i) {
#pragma unroll
                    for (int g = 0; g < 4; ++g) { const f32x4 e = *(const LAS f32x4*)(buf + EB_OFF + (32 * i + 8 * g + 4 * hi) * 4);
                        S[i][4 * g] *= e[0]; S[i][4 * g + 1] *= e[1]; S[i][4 * g + 2] *= e[2]; S[i][4 * g + 3] *= e[3]; }
#pragma unroll
                    for (int st = 0; st < 2; ++st) { const bf16x8 ka = *(const LAS bf16x8*)(buf + KHT_OFF + (32 * i + r32) * 80 + (16 * st + 8 * hi) * 2), vb = *(const LAS bf16x8*)(buf + VT_OFF + (32 * jv + r32) * 80 + (16 * st + 8 * hi) * 2);
                        S[i] = HG_MFMA(ka, vb, S[i]); }
                }
            }
        }
        __syncthreads();
#undef HG_LOAD
    }
}
}

namespace att {
constexpr int NW = 8, KVBLK = 64, NT = LSEQ / KVBLK;
constexpr float SCALE = 0.07216878364870322f;
constexpr float THR = 8.f;
constexpr int SHM_V = 16384, SHM_K = 64 * 384, V_OFF = 0, K_OFF = 2 * SHM_V, W_OFF = K_OFF + 2 * SHM_K;
#define KSWZ(row, colB) ((row) * 384 + ((colB) ^ ((((row) >> 1) & 7) << 4)))
#define SBAR() __builtin_amdgcn_sched_barrier(0)
DI int crow(int r, int hi) { return (r & 3) + 8 * (r >> 2) + 4 * hi; }
DI unsigned cvtpk(float lo, float hi) { return pk(lo, hi); }
DI int krow(int b, int k) { return k < LC ? TL + b * LC + k : b * SEQ + (k - LC); }

DI void partialSM(f32x16& p0, f32x16& p1, float& m_reg, float& mn, float& alpha) {
  constexpr float C = SCALE * 1.4426950408889634f;
  float pmax = p0[0];
#pragma unroll
  for (int r = 1; r < 16; ++r) pmax = fmaxf(pmax, p0[r]);
#pragma unroll
  for (int r = 0; r < 16; ++r) pmax = fmaxf(pmax, p1[r]);
  { auto rr = __builtin_amdgcn_permlane32_swap(__float_as_uint(pmax), __float_as_uint(pmax), false, false);
    pmax = fmaxf(__uint_as_float(rr[0]), __uint_as_float(rr[1])); }
  if (__builtin_expect(__all(pmax - m_reg <= THR / SCALE), 1)) { mn = m_reg; alpha = 1.f; }
  else { mn = fmaxf(m_reg, pmax); alpha = __builtin_amdgcn_exp2f((m_reg - mn) * C); m_reg = mn; }
  const float mnC = -mn * C;
#pragma unroll
  for (int r = 0; r < 16; ++r) p0[r] = fmaf(p0[r], C, mnC);
#pragma unroll
  for (int r = 0; r < 16; ++r) p1[r] = fmaf(p1[r], C, mnC);
#pragma unroll
  for (int r = 0; r < 16; ++r) p0[r] = __builtin_amdgcn_exp2f(p0[r]);
}
DI void finishSM(f32x16& p0, f32x16& p1, float alpha, float& l_reg, bf16x8& pa0, bf16x8& pa1, bf16x8& pa2, bf16x8& pa3) {
#pragma unroll
  for (int r = 0; r < 16; ++r) p1[r] = __builtin_amdgcn_exp2f(p1[r]);
  float ps = 0;
#pragma unroll
  for (int r = 0; r < 16; ++r) ps += p0[r];
#pragma unroll
  for (int r = 0; r < 16; ++r) ps += p1[r];
  { auto rr = __builtin_amdgcn_permlane32_swap(__float_as_uint(ps), __float_as_uint(ps), false, false);
    ps = __uint_as_float(rr[0]) + __uint_as_float(rr[1]); }
  l_reg = l_reg * alpha + ps;
#define PK4(P, BASE, OUT) do { unsigned a0 = cvtpk(P[BASE + 0], P[BASE + 1]), a1 = cvtpk(P[BASE + 2], P[BASE + 3]);   \
    unsigned b0 = cvtpk(P[BASE + 4], P[BASE + 5]), b1 = cvtpk(P[BASE + 6], P[BASE + 7]);                              \
    auto r0 = __builtin_amdgcn_permlane32_swap(a0, b0, false, false); auto r1 = __builtin_amdgcn_permlane32_swap(a1, b1, false, false); \
    u32x4 w = {r0[0], r1[0], r0[1], r1[1]}; OUT = __builtin_bit_cast(bf16x8, w); } while (0)
  PK4(p0, 0, pa0); PK4(p0, 8, pa1); PK4(p1, 0, pa2); PK4(p1, 8, pa3);
#undef PK4
}
DI void qkt(f32x16& p0, f32x16& p1, const LAS unsigned char* Ks, const bf16x8 (&qr)[12], int r32, int hi) {
#pragma unroll
  for (int r = 0; r < 16; ++r) { p0[r] = 0.f; p1[r] = 0.f; }
#pragma unroll
  for (int d0 = 0; d0 < 12; ++d0) { const int cb = (d0 * 16 + hi * 8) * 2;
    const bf16x8 b0 = *(const LAS bf16x8*)(Ks + KSWZ(r32, cb));
    const bf16x8 b1 = *(const LAS bf16x8*)(Ks + KSWZ(32 + r32, cb));
    p0 = __builtin_amdgcn_mfma_f32_32x32x16_bf16(b0, qr[d0], p0, 0, 0, 0);
    p1 = __builtin_amdgcn_mfma_f32_32x32x16_bf16(b1, qr[d0], p1, 0, 0, 0); }
}
DI int v_st(int k, int c) { const int kk = (k & ~0xC) | ((k & 4) << 1) | ((k & 8) >> 1); return ((kk >> 3) * 4 + (c >> 5)) * 512 + ((kk & 7) * 32 + (c & 31)) * 2; }
DI int v_rd_base(int lane) { return ((lane & 3) << 3) | (((lane >> 2) & 3) << 6) | (((lane >> 4) & 1) << 5) | (((lane >> 5) & 1) << 8); }
constexpr int v_rd_off(int d0, int ks, int half) { return d0 * 512 + ks * 4096 + half * 2048; }
template <int OFF> DI s16x4 tr_read(int vb) { s16x4 r; asm volatile("ds_read_b64_tr_b16 %0, %1 offset:%2" : "=&v"(r) : "v"(vb), "i"(OFF) : "memory"); return r; }
template <int D0> DI void pv_one(f32x16& od, int vb, bf16x8 pa0, bf16x8 pa1, bf16x8 pa2, bf16x8 pa3) {
  const s16x4 l0 = tr_read<v_rd_off(D0, 0, 0)>(vb), h0 = tr_read<v_rd_off(D0, 0, 1)>(vb), l1 = tr_read<v_rd_off(D0, 1, 0)>(vb), h1 = tr_read<v_rd_off(D0, 1, 1)>(vb);
  const s16x4 l2 = tr_read<v_rd_off(D0, 2, 0)>(vb), h2 = tr_read<v_rd_off(D0, 2, 1)>(vb), l3 = tr_read<v_rd_off(D0, 3, 0)>(vb), h3 = tr_read<v_rd_off(D0, 3, 1)>(vb);
  asm volatile("s_waitcnt lgkmcnt(0)" ::: "memory"); SBAR();
#define PKV(L, H) (bf16x8){L[0], L[1], L[2], L[3], H[0], H[1], H[2], H[3]}
  od = __builtin_amdgcn_mfma_f32_32x32x16_bf16(pa0, PKV(l0, h0), od, 0, 0, 0);
  od = __builtin_amdgcn_mfma_f32_32x32x16_bf16(pa1, PKV(l1, h1), od, 0, 0, 0);
  od = __builtin_amdgcn_mfma_f32_32x32x16_bf16(pa2, PKV(l2, h2), od, 0, 0, 0);
  od = __builtin_amdgcn_mfma_f32_32x32x16_bf16(pa3, PKV(l3, h3), od, 0, 0, 0);
#undef PKV
}
DI void pv_d0(f32x16 (&o)[4], int vb, bf16x8 pa0, bf16x8 pa1, bf16x8 pa2, bf16x8 pa3) {
  pv_one<0>(o[0], vb, pa0, pa1, pa2, pa3); pv_one<1>(o[1], vb, pa0, pa1, pa2, pa3); pv_one<2>(o[2], vb, pa0, pa1, pa2, pa3); pv_one<3>(o[3], vb, pa0, pa1, pa2, pa3);
}

DI void unit(const Args& a, LAS unsigned char* lds, int b, int h, int qb) {
  const bf16_t* Q = (const bf16_t*)(a.ws + WS_Q); const bf16_t* KV = (const bf16_t*)(a.ws + WS_KV); const bf16_t* KP = (const bf16_t*)(a.ws + WS_KP);
  const float* cs = (const float*)(a.ws + WS_ROPE); bf16_t* Ob = (bf16_t*)(a.ws + WS_OG);
  const int tid = tid_(), wid = tid >> 6, lane = tid & 63, r32 = lane & 31, hi = lane >> 5;
  LAS unsigned char* V_lds = lds + V_OFF; LAS unsigned char* K_lds = lds + K_OFF;
  LAS float* wsl = (LAS float*)(lds + W_OFF) + wid * 64; LAS float* li_l = wsl; LAS float* al_l = wsl + 32;
  float m_reg = -1e30f, l_reg = 0.f; f32x16 o[4]; bf16x8 qr[12];
#pragma unroll
  for (int d = 0; d < 4; ++d)
#pragma unroll
    for (int r = 0; r < 16; ++r) o[d][r] = 0.f;
  const int srow = qb * 256 + wid * 32 + r32;
  const bf16_t* Qw = Q + ((size_t)(b * SEQ + srow)) * 3072 + h * 192 + hi * 8;
#pragma unroll
  for (int d0 = 0; d0 < 8; ++d0) qr[d0] = *(const bf16x8*)(Qw + d0 * 16);
  {
      const u32x4 xa = *(const u32x4*)(Qw + 128), xb = *(const u32x4*)(Qw + 144), xc = *(const u32x4*)(Qw + 160), xd = *(const u32x4*)(Qw + 176);
      const float* cr = cs + ((srow >> 6) * 16 + hi * 8) * 2; const float* cc = cs + ((srow & 63) * 16 + hi * 8) * 2;
      float oa[8], ob[8], oc[8], od[8];
#pragma unroll
      for (int j = 0; j < 8; ++j) { const float x1 = (j & 1) ? bf_hi(xa[j >> 1]) : bf_lo(xa[j >> 1]), x2 = (j & 1) ? bf_hi(xb[j >> 1]) : bf_lo(xb[j >> 1]);
          const float c = cr[2 * j], s = cr[2 * j + 1]; oa[j] = x1 * c - x2 * s; ob[j] = x1 * s + x2 * c;
          const float y1 = (j & 1) ? bf_hi(xc[j >> 1]) : bf_lo(xc[j >> 1]), y2 = (j & 1) ? bf_hi(xd[j >> 1]) : bf_lo(xd[j >> 1]);
          const float c2 = cc[2 * j], s2 = cc[2 * j + 1]; oc[j] = y1 * c2 - y2 * s2; od[j] = y1 * s2 + y2 * c2; }
      u32x4 w;
      w.x = pk(oa[0], oa[1]); w.y = pk(oa[2], oa[3]); w.z = pk(oa[4], oa[5]); w.w = pk(oa[6], oa[7]); qr[8] = __builtin_bit_cast(bf16x8, w);
      w.x = pk(ob[0], ob[1]); w.y = pk(ob[2], ob[3]); w.z = pk(ob[4], ob[5]); w.w = pk(ob[6], ob[7]); qr[9] = __builtin_bit_cast(bf16x8, w);
      w.x = pk(oc[0], oc[1]); w.y = pk(oc[2], oc[3]); w.z = pk(oc[4], oc[5]); w.w = pk(oc[6], oc[7]); qr[10] = __builtin_bit_cast(bf16x8, w);
      w.x = pk(od[0], od[1]); w.y = pk(od[2], od[3]); w.z = pk(od[4], od[5]); w.w = pk(od[6], od[7]); qr[11] = __builtin_bit_cast(bf16x8, w);
  }
  const int sr = tid >> 4, sc = (tid & 15) * 8, vst0 = v_st(sr, sc), vst1 = v_st(32 + sr, sc);
  const int kr = tid >> 3, kc = (tid & 7) * 8;
  const int vb0 = (int)(uintptr_t)V_lds + v_rd_base(lane);
  bf16x8 vs0, vs1, ks0, ks1, kp0;
#define SLOAD(k0) do { const size_t ra = (size_t)krow(b, (k0) + sr) * 4096 + h * 256 + sc, rb2 = (size_t)krow(b, (k0) + 32 + sr) * 4096 + h * 256 + sc; \
    ks0 = *(const bf16x8*)(KV + ra); ks1 = *(const bf16x8*)(KV + rb2); vs0 = *(const bf16x8*)(KV + ra + 128); vs1 = *(const bf16x8*)(KV + rb2 + 128); \
    kp0 = *(const bf16x8*)(KP + (size_t)krow(b, (k0) + kr) * 64 + kc); } while (0)
#define SWRITE(bb) do { *(LAS bf16x8*)(V_lds + (bb) * SHM_V + vst0) = vs0; *(LAS bf16x8*)(V_lds + (bb) * SHM_V + vst1) = vs1; \
    *(LAS bf16x8*)(K_lds + (bb) * SHM_K + KSWZ(sr, sc * 2)) = ks0; *(LAS bf16x8*)(K_lds + (bb) * SHM_K + KSWZ(32 + sr, sc * 2)) = ks1; \
    *(LAS bf16x8*)(K_lds + (bb) * SHM_K + KSWZ(kr, 256 + kc * 2)) = kp0; } while (0)
  __syncthreads();
  SLOAD(0); SWRITE(0); __syncthreads();
  f32x16 p0, p1; float mn, al; bf16x8 pa0, pa1, pa2, pa3;
  for (int j = 0; j < NT; ++j) {
    const int bb = j & 1;
    if (j + 1 < NT) SLOAD((j + 1) * KVBLK);
    SBAR(); qkt(p0, p1, K_lds + bb * SHM_K, qr, r32, hi);
    partialSM(p0, p1, m_reg, mn, al);
    if (__any(al < 1.f)) { if (hi == 0) al_l[r32] = al; asm volatile("s_waitcnt lgkmcnt(0)" ::: "memory");
#pragma unroll
      for (int d = 0; d < 4; ++d)
#pragma unroll
        for (int r = 0; r < 16; ++r) o[d][r] *= al_l[crow(r, hi)]; }
    finishSM(p0, p1, al, l_reg, pa0, pa1, pa2, pa3); SBAR();
    pv_d0(o, vb0 + bb * SHM_V, pa0, pa1, pa2, pa3);
    if (j + 1 < NT) SWRITE(bb ^ 1);
    __syncthreads();
  }
  if (hi == 0) li_l[r32] = l_reg; asm volatile("s_waitcnt lgkmcnt(0)" ::: "memory");
  float rli[16];
#pragma unroll
  for (int r = 0; r < 16; ++r) rli[r] = __builtin_amdgcn_rcpf(li_l[crow(r, hi)]);
  unsigned char* Ow = (unsigned char*)Ob + ((size_t)(b * SEQ + qb * 256 + wid * 32)) * DM + h * 128;
#pragma unroll
  for (int r = 0; r < 16; ++r) { const int orow = crow(r, hi);
#pragma unroll
    for (int d0 = 0; d0 < 4; ++d0) { const unsigned w = pk8(clamp8(o[d0][r] * rli[r] * F8_OSCALE), 0.f, 0.f, 0.f); Ow[(size_t)orow * DM + d0 * 32 + r32] = (unsigned char)(w & 0xffu); } }
#undef SLOAD
#undef SWRITE
}
DI void phase(const Args& a, LAS unsigned char* lds, int G) {
  for (int u = blockIdx.x; u < NB * 16 * 16; u += G) {
    const int b = u >> 8, cc = u & 255, x = cc & 7, j = cc >> 3;
    unit(a, lds, b, 2 * x + (j >> 4), j & 15);
  }
  __syncthreads();
}
}

DI int balanced_grid(int nunits, int G) { if (nunits <= 0) return G; const int rounds = (nunits + G - 1) / G; return (nunits + rounds - 1) / rounds; }

template <bool F8, bool ACT8 = F8> DI void ph_moe_gu(const Args& a, int layer, int phase, LAS unsigned char* lds, int G) {
    unsigned char* ws = a.ws;
    moe_setup(a, layer, lds);
    const LAS int* tb256 = (const LAS int*)(lds + LCTL_OFF + 64); const LAS int* tbu = tb256; const LAS int* cn = (const LAS int*)(lds + LCTL_OFF + 256);
    const int GG = balanced_grid(tbu[32] * 16, G);
    if ((int)blockIdx.x >= GG) { cvq::service(a, lds, cvq::need(phase + 1), cvq::done_word(a, phase), 1u); return; }
    LAS unsigned* offs = (LAS unsigned*)(lds + TAB_OFF);
    constexpr int KE = F8 ? 1024 : 2048;
    typedef pg8::MoeSched<true, F8> SchedT; constexpr int RM = SchedT::RM;
    SchedT S; S.init(tbu, tb256, offs, 4096, KE, ws + WS_WGU + (size_t)layer * 32 * 4096 * 2048 * 2, GG, blockIdx.x); S.sig = cvq::done_word(a, phase);
    const int* ltok = (const int*)(ws + WS_LTOK);
    {
        const int nu = (S.nunits - S.c + GG - 1) / GG;
        for (int idx = threadIdx.x; idx < nu * RM; idx += 512) {
            const int ui = idx / RM, lr = idx - ui * RM; pg8::Unit u; S.next(ui, u);
            const int slot = u.aux + lr; const int tok = ltok[(size_t)u.e * TCAP + (slot < cn[u.e] ? slot : 0)];
            offs[idx] = (unsigned)tok * (unsigned)(KE * 2);
        }
        __syncthreads();
    }
    pg8::EpiGU<false, ACT8> E{(bf16_t*)(ws + WS_ACT), a.in[I_BGU] + (size_t)layer * 32 * 4096, F8 ? 1.0f / (F8_WSCALE * F8_ASCALE) : 1.0f};
    pg8::gemm_phase(lds, ws + WS_H2, KE, S, E);
    cvq::service(a, lds, cvq::need(phase + 1), nullptr, 0u);
}
template <bool F8> DI void ph_moe_dn(const Args& a, int layer, int phase, LAS unsigned char* lds, int G) {
    unsigned char* ws = a.ws;
    moe_setup(a, layer, lds);
    const LAS int* tb256 = (const LAS int*)(lds + LCTL_OFF + 64); const LAS int* tbu = tb256; const LAS int* cn = (const LAS int*)(lds + LCTL_OFF + 256);
    const int GG = balanced_grid(tbu[32] * 8, G);
    if ((int)blockIdx.x >= GG) { cvq::service(a, lds, cvq::need(phase + 1), cvq::done_word(a, phase), 1u); return; }
    constexpr int KE = F8 ? 1024 : 2048;
    pg8::MoeSched<false, F8> S; S.init(tbu, tb256, nullptr, 2048, KE, ws + WS_WDN + (size_t)layer * 32 * 2048 * 2048 * 2, GG, blockIdx.x); S.sig = cvq::done_word(a, phase);
    pg8::EpiDN<false> E{(bf16_t*)(ws + WS_Y2), a.in[I_BDN] + (size_t)layer * 32 * 2048, (const float*)(ws + WS_LGATE), cn, F8 ? 1.0f / (F8_WSCALE_DN * F8_ACTSCALE) : 1.0f};
    pg8::gemm_phase(lds, ws + WS_ACT, KE, S, E);
    cvq::service(a, lds, cvq::need(phase + 1), nullptr, 0u);
}

constexpr int N_PHASES = 19;
__global__ void __launch_bounds__(512, 2) mk_fwd(Args args) {
    extern __shared__ __attribute__((aligned(16))) unsigned char lds_raw[];
    LAS unsigned char* lds = (LAS unsigned char*)lds_raw;
    const int G = gridDim.x;
    unsigned char* ws = args.ws;
    for (int u = threadIdx.x; u < 256; u += 512) ((LAS unsigned*)(lds + LCTL_OFF))[u] = 0u;
    __syncthreads();
#if MK_PER_PHASE
#define GRID_BAR() do { } while (0)
#else
    XcdBarrier bar = xcd_barrier_post((unsigned*)(ws + WS_CTL), (volatile LAS unsigned*)(lds + LCTL_OFF));
#define GRID_BAR() xcd_barrier(bar)
#endif
    const int lo = args.ph_lo, hi = args.ph_hi;
#ifndef MK_MASK
#define MK_MASK 0xFFFFFFu
#endif
#define IN(k) (((MK_MASK >> (k)) & 1u) && lo <= (k) && (k) < hi)
#define SEAM(k) do { if (IN((k) + 1)) GRID_BAR(); } while (0)
    const float* modv = (const float*)(ws + WS_MODV);

#ifndef MK_REP
#define MK_REP 0u
#endif
#define PHASE(k, ...) do { if (IN(k)) { __VA_ARGS__; if ((MK_REP >> (k)) & 1u) { GRID_BAR(); __VA_ARGS__; } cvq::service(args, lds, cvq::need((k) + 1), nullptr, 0u); SEAM(k); } } while (0)
#define GEMM_PHASE(k, GG, M_, N_, ...) GEMM_PHASE_U(k, GG, ((M_) / 256) * ((N_) / 256), __VA_ARGS__)
#define GEMM_PHASE_U(k, GG, NU_, ...) do { if (IN(k)) { const int GG = balanced_grid((NU_), G); \
        if ((int)blockIdx.x < GG) { __VA_ARGS__; cvq::service(args, lds, cvq::need((k) + 1), nullptr, 0u); } \
        else cvq::service(args, lds, cvq::need((k) + 1), cvq::done_word(args, (k)), 1u); \
        SEAM(k); } } while (0)
    PHASE(0, p0_prologue(args, lds, G));
    PHASE(1, ph_modulate(args.in[I_X], args.in[I_CTX], modv, 0, 1, (bf16_t*)(ws + WS_H), G));
    GEMM_PHASE(2, GG, T, HGN, { pg8::PlainSched<true> S; S.init(T, HGN, 1024, ws + WS_WHGIN, GG, blockIdx.x); S.sig = cvq::done_word(args, 2);
               pg8::EpiHgIn E{(bf16_t*)(ws + WS_P), (const float*)(ws + WS_LB), 1.0f / (F8_WSCALE * F8_ASCALE)}; pg8::gemm_phase(lds, ws + WS_H, 1024, S, E); });
    if (IN(3)) {
        if ((int)blockIdx.x < hg::NCHAIN) { hg::scan(args, lds, hg::NCHAIN); cvq::signal_done(args, 3); cvq::service(args, lds, cvq::need(4), nullptr, 0u); }
        else cvq::service(args, lds, cvq::need(4), cvq::done_word(args, 3), (unsigned)hg::NCHAIN);
        SEAM(3);
    }
    PHASE(4, ph_hg_combine(args, G));
    GEMM_PHASE_U(5, GG, (T / 256) * 8, { pg8::PlainSched<true> S; S.init(T, 2048, 1024, ws + WS_WHGO, GG, blockIdx.x); S.sig = cvq::done_word(args, 5);
               pg8::EpiBf16<false> E{(bf16_t*)(ws + WS_Y), 2048, 2048, 1.0f / (F8_WSCALE_DN * F8_OGSCALE)}; pg8::gemm_phase(lds, ws + WS_OG, 1024, S, E); });
    PHASE(6, ph_post_router(args, 0, args.in[I_X], args.in[I_CTX], (const bf16_t*)(ws + WS_Y), T, lds, G));
    if (IN(7)) { ph_moe_gu<true>(args, 0, 7, lds, G); SEAM(7); }
    if (IN(8)) { ph_moe_dn<true>(args, 0, 8, lds, G); SEAM(8); }
    PHASE(9, ph_post_ffn(args, 0, T, (float*)(ws + WS_X2), true, lds, G));
    GEMM_PHASE(10, GG, T, 1280, { pg8::PlainSched<> S; S.init(T, 1280, 2048, ws + WS_WMIN, GG, blockIdx.x); S.sig = cvq::done_word(args, 10); pg8::EpiF32 E{(float*)(ws + WS_PM), 1088, 1088};
                pg8::gemm_phase(lds, ws + WS_H, 2048, S, E); });
    PHASE(11, ph_mla_local(args, G));
    PHASE(12, { { pg8::PlainSched<> S; S.init(TL, 3072, 512, ws + WS_WUQ, G, blockIdx.x); pg8::EpiBf16<> E{(bf16_t*)(ws + WS_Q), 3072, 3072, 1.0f}; pg8::gemm_phase(lds, ws + WS_CQN, 512, S, E); }
                { pg8::PlainSched<> S; S.init(T, 4096, 512, ws + WS_WUKV, G, blockIdx.x); pg8::EpiBf16<> E{(bf16_t*)(ws + WS_KV), 4096, 4096, 1.0f}; pg8::gemm_phase(lds, ws + WS_CKVN, 512, S, E); } });
    PHASE(13, att::phase(args, lds, G));
    PHASE(14, { pg8::PlainSched<true> S; S.init(TL, 2048, 1024, ws + WS_WMO, G, blockIdx.x); pg8::EpiBf16<false> E{(bf16_t*)(ws + WS_Y), 2048, 2048, 1.0f / (F8_WSCALE_DN * F8_OSCALE)};
                pg8::gemm_phase(lds, ws + WS_OG, 1024, S, E); });
    PHASE(15, ph_post_router(args, 1, (const float*)(ws + WS_X2), (const float*)(ws + WS_X2) + (size_t)TL * DM, (const bf16_t*)(ws + WS_Y), TL, lds, G));
    if (IN(16)) { ph_moe_gu<true>(args, 1, 16, lds, G); SEAM(16); }
    if (IN(17)) { ph_moe_dn<true>(args, 1, 17, lds, G); SEAM(17); }
    if (IN(18)) { ph_post_ffn(args, 1, TL, args.out, false, lds, G); if ((MK_REP >> 18) & 1u) { GRID_BAR(); ph_post_ffn(args, 1, TL, args.out, false, lds, G); } }
#undef GEMM_PHASE
#undef GEMM_PHASE_U
#undef PHASE
#undef IN
#undef SEAM
}

extern "C" void kernel_launch(void* const* d_in, const int* in_sizes, int n_in, void* d_out, int out_size, void* d_ws, size_t ws_size, hipStream_t stream) {
    static int grid = 0;
    if (grid == 0) {
        if (n_in != 24 || out_size != TL * DM || ws_size < WS_END) { fprintf(stderr, "kernel_launch: shape mismatch: n_in %d out %d ws %zu (need %zu)\n", n_in, out_size, ws_size, (size_t)WS_END); grid = -1; return; }
        int dev = 0, cus = 0, per_cu = 0;
        if (hipGetDevice(&dev) != hipSuccess || hipDeviceGetAttribute(&cus, hipDeviceAttributeMultiprocessorCount, dev) != hipSuccess) { grid = -1; return; }
        if (hipFuncSetAttribute((const void*)mk_fwd, hipFuncAttributeMaxDynamicSharedMemorySize, LDS_BYTES) != hipSuccess) { fprintf(stderr, "kernel_launch: hipFuncSetAttribute failed\n"); grid = -1; return; }
        if (hipOccupancyMaxActiveBlocksPerMultiprocessor(&per_cu, (const void*)mk_fwd, 512, LDS_BYTES) != hipSuccess || per_cu < 1) fprintf(stderr, "kernel_launch: occupancy query reports %d\n", per_cu);
        (void)hipGetLastError();
        grid = cus;
        if (grid != 256) { fprintf(stderr, "kernel_launch: built for 256 CUs, device has %d\n", cus); grid = -1; return; }
    }
    if (grid < 0) return;
    (void)hipMemsetAsync((char*)d_ws + WS_CTL, 0, CTL_BYTES, stream);
    Args a{};
    for (int i = 0; i < 24; ++i) a.in[i] = (const float*)d_in[i];
    a.out = (float*)d_out; a.ws = (unsigned char*)d_ws;
#if MK_PER_PHASE
    for (int p = 0; p < N_PHASES; ++p) { a.ph_lo = p; a.ph_hi = p + 1; hipLaunchKernelGGL(mk_fwd, dim3(grid), dim3(512), LDS_BYTES, stream, a); }
#else
    a.ph_lo = 0; a.ph_hi = N_PHASES;
    hipLaunchKernelGGL(mk_fwd, dim3(grid), dim3(512), LDS_BYTES, stream, a);
#endif
    const hipError_t le = hipPeekAtLastError();
    if (le != hipSuccess) fprintf(stderr, "kernel_launch: launch failed: %s\n", hipGetErrorName(le));
}
```

```cpp
#include <hip/hip_runtime.h>
#include <stdio.h>
#include <stdint.h>

#ifndef MK_PER_PHASE
#define MK_PER_PHASE 0
#endif

#define LAS __attribute__((address_space(3)))
#define DI __device__ __forceinline__
typedef unsigned short bf16_t;
typedef short bf16x8 __attribute__((ext_vector_type(8)));
typedef short s16x4 __attribute__((ext_vector_type(4)));
typedef float f32x2 __attribute__((ext_vector_type(2)));
typedef float f32x4 __attribute__((ext_vector_type(4)));
typedef float f32x16 __attribute__((ext_vector_type(16)));
typedef unsigned u32x2 __attribute__((ext_vector_type(2)));
typedef unsigned u32x4 __attribute__((ext_vector_type(4)));
typedef __bf16 bfv2 __attribute__((ext_vector_type(2)));

typedef int v4i __attribute__((ext_vector_type(4)));
typedef int v8i __attribute__((ext_vector_type(8)));
constexpr float F8_WSCALE = 256.0f, F8_ASCALE = 8.0f, F8_WSCALE_DN = 512.0f, F8_ACTSCALE = 4.0f, F8_OGSCALE = 8.0f, F8_OSCALE = 32.0f;
DI float clamp8(float x) { return __builtin_amdgcn_fmed3f(x, -440.0f, 440.0f); }
DI unsigned pk8(float a, float b, float c, float d) { int w = __builtin_amdgcn_cvt_pk_fp8_f32(a, b, 0, false); w = __builtin_amdgcn_cvt_pk_fp8_f32(c, d, w, true); return (unsigned)w; }
DI unsigned pk(float a, float b) { f32x2 v = {a, b}; bfv2 r = __builtin_convertvector(v, bfv2); return __builtin_bit_cast(unsigned, r); }
DI float bf_lo(unsigned w) { return __uint_as_float(w << 16); }
DI float bf_hi(unsigned w) { return __uint_as_float(w & 0xffff0000u); }
DI float wave_sum(float v) { for (int o = 32; o >= 1; o >>= 1) v += __shfl_xor(v, o); return v; }
DI float sigm(float x) { return __builtin_amdgcn_rcpf(1.0f + __expf(-x)); }
DI int tid_() { int t = threadIdx.x; asm volatile("" : "+v"(t)); return t; }

constexpr int DM = 2048, NB = 4, SEQ = 4096, LC = 256, TL = NB * SEQ, TCX = NB * LC, T = TL + TCX, LSEQ = SEQ + LC;
constexpr int NE = 32, TCAP = T, HGN = 10240, MAXRT = 304, NMOD = 12288;
constexpr float DN_ALPHA = 1.4142135623730951f;
constexpr float LN_EPS = 1e-5f, RMS_EPS = 1e-6f;

constexpr size_t al256(size_t x) { return (x + 255) / 256 * 256; }
constexpr size_t WS_CTL = 0, CTL_BYTES = 65536;
constexpr size_t CTL_CNT0 = 16384, CTL_CNT1 = 24576;
constexpr size_t WS_MODV = WS_CTL + CTL_BYTES;
constexpr size_t WS_LB = WS_MODV + al256((size_t)2 * 5 * NMOD * 4);
constexpr size_t WS_ROPE = WS_LB + al256(2 * 2048 * 4);
constexpr size_t WS_WGU = WS_ROPE + al256(64 * 16 * 2 * 4);
constexpr size_t WS_WDN = WS_WGU + (size_t)2 * 32 * 4096 * 2048 * 2;
constexpr size_t WS_WHGIN = WS_WDN + (size_t)2 * 32 * 2048 * 2048 * 2;
constexpr size_t WS_WHGO = WS_WHGIN + (size_t)HGN * 2048 * 2;
constexpr size_t WS_WMIN = WS_WHGO + (size_t)2048 * 2048 * 2;
constexpr size_t WS_WUQ = WS_WMIN + (size_t)1280 * 2048 * 2;
constexpr size_t WS_WUKV = WS_WUQ + (size_t)3072 * 512 * 2;
constexpr size_t WS_WMO = WS_WUKV + (size_t)4096 * 512 * 2;
constexpr size_t WS_H = WS_WMO + (size_t)2048 * 2048 * 2;
constexpr size_t WS_P = WS_H + (size_t)T * 2048 * 2;
constexpr size_t WS_OF = WS_P + (size_t)T * HGN * 2;
constexpr size_t WS_OB = WS_OF + (size_t)T * 2048 * 2;
constexpr size_t WS_OG = WS_OB + (size_t)T * 2048 * 2;
constexpr size_t WS_Y = WS_OG + (size_t)T * 2048 * 2;
constexpr size_t WS_X1 = WS_Y + (size_t)T * 2048 * 2;
constexpr size_t WS_X2 = WS_X1 + (size_t)T * 2048 * 4;
constexpr size_t WS_H2 = WS_X2 + (size_t)T * 2048 * 4;
constexpr size_t WS_LTOK = WS_H2 + (size_t)T * 2048 * 2;
constexpr size_t WS_LGATE = WS_LTOK + al256((size_t)NE * TCAP * 4);
constexpr size_t WS_TOKES = WS_LGATE + al256((size_t)NE * TCAP * 4);
constexpr size_t WS_ACT = WS_TOKES + al256((size_t)T * 4 * 4);
constexpr size_t WS_Y2 = WS_ACT + (size_t)MAXRT * 256 * 2048 * 2;
constexpr size_t WS_PM = WS_Y2 + (size_t)MAXRT * 256 * 2048 * 2;
constexpr size_t WS_CQN = WS_PM + al256((size_t)T * 1088 * 4);
constexpr size_t WS_CKVN = WS_CQN + (size_t)TL * 512 * 2;
constexpr size_t WS_KP = WS_CKVN + (size_t)T * 512 * 2;
constexpr size_t WS_Q = WS_KP + (size_t)T * 64 * 2;
constexpr size_t WS_KV = WS_Q + (size_t)TL * 3072 * 2;
constexpr size_t WS_END = WS_KV + (size_t)T * 4096 * 2;

constexpr int RING_BYTES = 131072, TAB_OFF = 131072, TAB_BYTES = 24576, LCTL_OFF = TAB_OFF + TAB_BYTES, LDS_BYTES = LCTL_OFF + 1024;

#define XB_TMO      128
#define XB_XCNT(j)  (256  + 64 * (j))
#define XB_XSUB(j)  (1280 + 64 * (j))
#define XB_XGEN(j)  (2304 + 64 * (j))
#define XB_TOP      3328
#define XB_TOPGEN   3392
#define XCD_BAR_WORDS 3456
#define XB_SPIN_CAP (1u << 22)

__device__ __forceinline__ unsigned xb_ld(unsigned* p)              { return __hip_atomic_load(p, __ATOMIC_RELAXED, __HIP_MEMORY_SCOPE_AGENT); }
__device__ __forceinline__ unsigned xb_add(unsigned* p, unsigned v) { return __hip_atomic_fetch_add(p, v, __ATOMIC_RELAXED, __HIP_MEMORY_SCOPE_AGENT); }
__device__ __forceinline__ unsigned xb_xcc_id() { return (unsigned)__builtin_amdgcn_s_getreg((3 << 11) | 20) & 0xFu; }
#define XB_SPIN(cond, bar) do { unsigned _sp = 0; while (cond) { __builtin_amdgcn_s_sleep(1); \
    if ((++_sp & 255u) == 0u) { if (xb_ld(&(bar)[XB_TMO])) break; if (_sp > XB_SPIN_CAP) { atomicAdd(&(bar)[XB_TMO], 1u); break; } } } } while (0)

struct XcdBarrier { unsigned* bar; unsigned x; volatile LAS unsigned* st; };

__device__ __forceinline__ XcdBarrier xcd_barrier_post(unsigned* bar, volatile LAS unsigned* st) {
    XcdBarrier b; b.bar = bar; b.x = xb_xcc_id(); b.st = st;
    if (threadIdx.x == 0) (void)xb_add(&bar[XB_XCNT(b.x)], 1u);
    return b;
}
__device__ __forceinline__ void xcd_barrier_complete(unsigned* bar, unsigned x, unsigned& nloc, unsigned& nx) {
    const unsigned G = gridDim.x * gridDim.y * gridDim.z;
    unsigned sum, cnt, mine, sp = 0u;
    for (;;) {
        sum = 0u; cnt = 0u; mine = 0u;
#pragma unroll
        for (unsigned j = 0; j < 16; ++j) { const unsigned c = xb_ld(&bar[XB_XCNT(j)]); sum += c; cnt += (c > 0u) ? 1u : 0u; mine = (j == x) ? c : mine; }
        if (sum == G) break;
        __builtin_amdgcn_s_sleep(1);
        if ((++sp & 255u) == 0u) { if (xb_ld(&bar[XB_TMO])) break; if (sp > XB_SPIN_CAP) { atomicAdd(&bar[XB_TMO], 1u); break; } }
    }
    nloc = mine > 0u ? mine : 1u; nx = cnt > 0u ? cnt : 1u;
}
__device__ __forceinline__ void xcd_barrier(const XcdBarrier& b) {
    asm volatile("s_waitcnt vmcnt(0)" ::: "memory");
    __syncthreads();
    if (threadIdx.x == 0) {
        unsigned* bar = b.bar;
        __builtin_amdgcn_s_waitcnt(0);
        unsigned nloc = b.st[0], nx = b.st[1];
        if (nloc == 0u) { xcd_barrier_complete(bar, b.x, nloc, nx); b.st[0] = nloc; b.st[1] = nx; }
        const unsigned old = xb_add(&bar[XB_XSUB(b.x)], 1u);
        const unsigned gen = old / nloc;
        if (old + 1u == (gen + 1u) * nloc) {
            __builtin_amdgcn_fence(__ATOMIC_RELEASE, "agent");
            asm volatile("s_waitcnt vmcnt(0)" ::: "memory");
            const unsigned og = xb_add(&bar[XB_TOP], 1u);
            const unsigned tg = og / nx;
            if (og + 1u == (tg + 1u) * nx) xb_add(&bar[XB_TOPGEN], 1u);
            else XB_SPIN(xb_ld(&bar[XB_TOPGEN]) == tg, bar);
            __builtin_amdgcn_fence(__ATOMIC_ACQUIRE, "agent");
            xb_add(&bar[XB_XGEN(b.x)], 1u);
            asm volatile("s_waitcnt vmcnt(0)" ::: "memory");
        } else {
            XB_SPIN(xb_ld(&bar[XB_XGEN(b.x)]) == gen, bar);
            __builtin_amdgcn_fence(__ATOMIC_ACQUIRE, "agent");
            asm volatile("s_waitcnt vmcnt(0)" ::: "memory");
        }
    }
    __syncthreads();
}

namespace pg8 {
constexpr int BM = 256, BK = 64, HALF = 128, HTB = HALF * BK * 2, NXCD = 8, WGM = 8;
DI int lds_byte(int r, int c) { const int st = (r >> 4) * 2 + (c >> 5), rr = r & 15, cc = c & 31, ob = rr * 64 + cc * 2; return st * 1024 + (ob ^ (((ob >> 9) & 1) << 5)); }
DI void stage_rc(int b, int& R, int& C) { const int st = b / 1024, sb = b % 1024, swz = sb ^ (((sb >> 9) & 1) << 5); R = (st >> 1) * 16 + swz / 64; C = (st & 1) * 32 + (swz % 64) / 2; }
DI int perm32(int rho) { const int n = rho >> 4, i = rho & 15; return 8 * (i >> 2) + 4 * n + (i & 3); }

struct Unit { const char* B; int row0, col0, e, aux; };

template <bool FP8_ = false> struct PlainSched {
    static constexpr int RM = 256;
    int nM, nN, nwg, G, c, K; const char* Bt; unsigned* sig = nullptr;
    DI void init(int M, int N, int K_, const void* Bt_, int G_, int c_) { nM = M / RM; nN = N / BM; nwg = nM * nN; G = G_; c = c_; K = K_; Bt = (const char*)Bt_; }
    DI bool next(int i, Unit& u) const {
        const long L = (long)i * G + c; if (L >= nwg) return false;
        int wgid = (int)L; { const int q = nwg / NXCD, r = nwg % NXCD, xcd = wgid % NXCD, off = wgid / NXCD; wgid = (xcd < r ? xcd * (q + 1) : r * (q + 1) + (xcd - r) * q) + off; }
        const int nig = WGM * nN, gid = wgid / nig, fm = gid * WGM, gsz = (nM - fm) < WGM ? (nM - fm) : WGM;
        const int pm = fm + ((wgid % nig) % gsz), pn = (wgid % nig) / gsz;
        u.row0 = pm * RM; u.col0 = pn * BM; u.e = 0; u.aux = 0; u.B = Bt + (size_t)pn * BM * K * 2; return true;
    }
    static constexpr bool GATHER = false, FP8 = FP8_, HM = false;
    DI void avoff(int, const Unit&, const int (&)[2], const int (&)[2], unsigned (&)[2][2]) const {}
};
template <bool GATHER_, bool FP8_ = false> struct MoeSched {
    static constexpr bool GATHER = GATHER_, FP8 = FP8_, HM = false;
    static constexpr int RM = HM ? 128 : 256;
    const LAS int* tb; const LAS int* tb256; const LAS unsigned* offs; int NT, nunits, G, c, K, N; const char* Wt; unsigned* sig = nullptr;
    DI void init(const LAS int* tb_, const LAS int* tb256_, const LAS unsigned* offs_, int N_, int K_, const void* Wt_, int G_, int blk) {
        tb = tb_; tb256 = tb256_; offs = offs_; N = N_; K = K_; NT = N_ / BM; Wt = (const char*)Wt_; G = G_; nunits = tb_[32] * NT;
        { const int q = G_ / 8, r = G_ % 8, x = blk % 8; c = x * q + (x < r ? x : r) + blk / 8; }
    }
    DI bool next(int i, Unit& u) const {
        const int L = i * G + c; if (L >= nunits) return false;
        int rt = L / NT, pn = L - rt * NT;
        if (NT == 16 && L < 64 * (tb[32] >> 2)) { const int g = L >> 6, sub = L & 63; rt = 4 * g + ((sub & 31) >> 3); pn = (sub >> 5) * 8 + (sub & 7); }
        int e = 0;
#pragma unroll
        for (int st = 16; st >= 1; st >>= 1) e += (tb[e + st] <= rt) ? st : 0;
        e = __builtin_amdgcn_readfirstlane(e);
        u.e = e; u.aux = __builtin_amdgcn_readfirstlane((rt - tb[e]) * RM); u.row0 = __builtin_amdgcn_readfirstlane(tb256[e]) * BM + u.aux; u.col0 = pn * BM; u.B = Wt + ((size_t)e * N + (size_t)pn * BM) * K * 2; return true;
    }
    DI void avoff(int ui, const Unit&, const int (&R)[2], const int (&C)[2], unsigned (&vo)[2][2]) const {
#pragma unroll
        for (int h = 0; h < 2; ++h)
#pragma unroll
            for (int i = 0; i < 2; ++i) vo[h][i] = offs[ui * RM + (HM ? 0 : h * HALF) + R[i]] + (unsigned)C[i] * 2u;
    }
};

template <class Epi, class Sched>
DI void gemm_phase(LAS unsigned char* lds, const void* Abase_, int K, const Sched& S, const Epi& E) {
    const char* Abase = (const char*)Abase_;
    const int tid = tid_(), wid = __builtin_amdgcn_readfirstlane(tid >> 6), lane = tid & 63, wr = wid >> 2, wc = wid & 3, fr = lane & 15, fq = lane >> 4;
    const int nt = K / BK;
    int R[2], C[2]; unsigned voffB[2];
#pragma unroll
    for (int i = 0; i < 2; ++i) { stage_rc(tid * 16 + i * 8192, R[i], C[i]); const int Rb = (R[i] & ~31) + perm32(R[i] & 31); voffB[i] = (unsigned)(Rb * K + C[i]) * 2u; }
    const size_t kstep = (size_t)(BK * 2);
    const size_t hstep = (size_t)HALF * K * 2;
    const unsigned ldsw = (unsigned)wid * 1024u;
    const int aoff = lds_byte(wr * 64 + fr, fq * 8), boff = lds_byte(wc * 32 + fr, fq * 8);
#define PG8_SA(b, h) (((b) * 2 + (h)) * HTB)
#define PG8_SB(b, h) ((4 + (b) * 2 + (h)) * HTB)
#define PG8_STAGE(bufoff, gbase, voff) do { const char* gb_; { const unsigned long long t_ = (unsigned long long)(gbase); unsigned lo_ = __builtin_amdgcn_readfirstlane((unsigned)t_), hi_ = __builtin_amdgcn_readfirstlane((unsigned)(t_ >> 32)); \
        asm volatile("" : "+s"(lo_), "+s"(hi_)); gb_ = (const char*)(((unsigned long long)hi_ << 32) | lo_); }     \
        _Pragma("unroll") for (int _i = 0; _i < 2; ++_i) \
        __builtin_amdgcn_global_load_lds((const unsigned*)(gb_ + (voff)[_i]), (LAS unsigned*)(lds + (bufoff) + ldsw + _i * 8192), 16, 0, 0); } while (0)
#define PG8_LDA(dst, b, h) do { if constexpr (Sched::FP8) { const LAS unsigned char* p_ = lds + PG8_SA(b, h) + aoff; _Pragma("unroll") for (int m = 0; m < 4; ++m) \
            dst##8[m] = __builtin_shufflevector(*(const LAS v4i*)(p_ + m * 2048), *(const LAS v4i*)(p_ + m * 2048 + 1024), 0, 1, 2, 3, 4, 5, 6, 7); } \
        else { _Pragma("unroll") for (int m = 0; m < 4; ++m) _Pragma("unroll") for (int k = 0; k < 2; ++k) dst[m][k] = *(const LAS bf16x8*)(lds + PG8_SA(b, h) + aoff + m * 2048 + k * 1024); } } while (0)
#define PG8_LDB(dst, b, h) do { if constexpr (Sched::FP8) { const LAS unsigned char* p_ = lds + PG8_SB(b, h) + boff; _Pragma("unroll") for (int n = 0; n < 2; ++n) \
            dst##8[n] = __builtin_shufflevector(*(const LAS v4i*)(p_ + n * 2048), *(const LAS v4i*)(p_ + n * 2048 + 1024), 0, 1, 2, 3, 4, 5, 6, 7); } \
        else { _Pragma("unroll") for (int n = 0; n < 2; ++n) _Pragma("unroll") for (int k = 0; k < 2; ++k) dst[n][k] = *(const LAS bf16x8*)(lds + PG8_SB(b, h) + boff + n * 2048 + k * 1024); } } while (0)
#define PG8_MMA(ai, bj, At, Bt) do { __builtin_amdgcn_s_setprio(1); \
        if constexpr (Sched::FP8) { _Pragma("unroll") for (int m = 0; m < 4; ++m) _Pragma("unroll") for (int n = 0; n < 2; ++n) \
            acc[ai][bj][m][n] = __builtin_amdgcn_mfma_scale_f32_16x16x128_f8f6f4(Bt##8[n], At##8[m], acc[ai][bj][m][n], 0, 0, 0, 0, 0, 0); } \
        else { _Pragma("unroll") for (int m = 0; m < 4; ++m) _Pragma("unroll") for (int n = 0; n < 2; ++n) _Pragma("unroll") for (int k = 0; k < 2; ++k) \
            acc[ai][bj][m][n] = __builtin_amdgcn_mfma_f32_16x16x32_bf16(Bt[n][k], At[m][k], acc[ai][bj][m][n], 0, 0, 0); } \
        __builtin_amdgcn_s_setprio(0); } while (0)
#define PG8_MMAZ(ai, bj, At, Bt, zc) do { __builtin_amdgcn_s_setprio(1); \
        if (zc) { const f32x4 z_ = {0.f, 0.f, 0.f, 0.f}; _Pragma("unroll") for (int m = 0; m < 4; ++m) _Pragma("unroll") for (int n = 0; n < 2; ++n) \
            acc[ai][bj][m][n] = __builtin_amdgcn_mfma_scale_f32_16x16x128_f8f6f4(Bt##8[n], At##8[m], z_, 0, 0, 0, 0, 0, 0); }     \
        else { _Pragma("unroll") for (int m = 0; m < 4; ++m) _Pragma("unroll") for (int n = 0; n < 2; ++n) \
            acc[ai][bj][m][n] = __builtin_amdgcn_mfma_scale_f32_16x16x128_f8f6f4(Bt##8[n], At##8[m], acc[ai][bj][m][n], 0, 0, 0, 0, 0, 0); } \
        __builtin_amdgcn_s_setprio(0); } while (0)
#define PG8_WAIT_V(n) asm volatile("s_waitcnt vmcnt(" #n ")" ::: "memory")
#define PG8_WAIT_L(n) asm volatile("s_waitcnt lgkmcnt(" #n ")" ::: "memory")
#define PG8_BAR __builtin_amdgcn_s_barrier()
#define PG8_SCHED __builtin_amdgcn_sched_barrier(0)
    Unit cur, nxt; int ui = 0;
    if (!S.next(0, cur)) return;
    f32x4 acc[2][2][4][2];
#pragma unroll
    for (int a = 0; a < 2; ++a)
#pragma unroll
        for (int b = 0; b < 2; ++b)
#pragma unroll
            for (int m = 0; m < 4; ++m)
#pragma unroll
                for (int n = 0; n < 2; ++n) acc[a][b][m][n] = (f32x4){0.f, 0.f, 0.f, 0.f};
    bf16x8 At[4][2], B0[2][2], B1[2][2];
    v8i At8[4], B08[2], B18[2];
    constexpr bool GA = Sched::GATHER, HM = Sched::HM;
    unsigned voffA[2];
#pragma unroll
    for (int i = 0; i < 2; ++i) voffA[i] = (unsigned)(R[i] * K + C[i]) * 2u;
    unsigned cvo[2][2];
    if constexpr (GA) S.avoff(0, cur, R, C, cvo);
    const size_t tstepA = (size_t)K * 2;
    const char* cA = GA ? Abase : Abase + (size_t)cur.row0 * tstepA;
    const char* cB = cur.B;
#define PG8_STAGE_A(bufoff, ab, vo, h, kb) do { if constexpr (GA) { PG8_STAGE(bufoff, Abase + (kb), (vo)[h]); } else { PG8_STAGE(bufoff, (ab) + (size_t)(h) * hstep + (kb), voffA); } } while (0)
    if constexpr (HM) {
        PG8_STAGE(PG8_SB(0, 0), cB, voffB); PG8_STAGE_A(PG8_SA(0, 0), cA, cvo, 0, 0); PG8_STAGE(PG8_SB(0, 1), cB + hstep, voffB);
        if (wr == 1) PG8_BAR;
        PG8_WAIT_V(0); PG8_BAR;
        PG8_STAGE(PG8_SB(1, 0), cB + kstep, voffB); PG8_STAGE_A(PG8_SA(1, 0), cA, cvo, 0, kstep);
        PG8_WAIT_V(6); PG8_BAR;
    } else if constexpr (Sched::FP8) {
        PG8_STAGE_A(PG8_SA(0, 0), cA, cvo, 0, 0); PG8_STAGE(PG8_SB(0, 1), cB + hstep, voffB); PG8_STAGE_A(PG8_SA(0, 1), cA, cvo, 1, 0); PG8_STAGE(PG8_SB(0, 0), cB, voffB);
        PG8_STAGE_A(PG8_SA(1, 0), cA, cvo, 0, kstep); PG8_STAGE(PG8_SB(1, 1), cB + hstep + kstep, voffB); PG8_STAGE_A(PG8_SA(1, 1), cA, cvo, 1, kstep);
        if (wr == 1) PG8_BAR;
        PG8_WAIT_V(6); PG8_BAR; PG8_BAR;
    } else {
        PG8_STAGE(PG8_SB(0, 0), cB, voffB); PG8_STAGE(PG8_SB(0, 1), cB + hstep, voffB); PG8_STAGE_A(PG8_SA(0, 0), cA, cvo, 0, 0); PG8_STAGE_A(PG8_SA(0, 1), cA, cvo, 1, 0);
        if (wr == 1) PG8_BAR;
        PG8_WAIT_V(2); PG8_BAR;
        PG8_STAGE(PG8_SB(1, 0), cB + kstep, voffB); PG8_STAGE_A(PG8_SA(1, 0), cA, cvo, 0, kstep); PG8_STAGE(PG8_SB(1, 1), cB + hstep + kstep, voffB);
        PG8_WAIT_V(6); PG8_BAR;
    }
    for (;;) {
        const bool has_next = S.next(ui + 1, nxt);
        if (!has_next && S.sig != nullptr && blockIdx.x == 0 && threadIdx.x == 0) __hip_atomic_fetch_add(S.sig, 1u, __ATOMIC_RELAXED, __HIP_MEMORY_SCOPE_AGENT);
        const char* nB = has_next ? nxt.B : cB;
        const char* nA = GA ? Abase : (has_next ? Abase + (size_t)nxt.row0 * tstepA : cA);
        for (int t = 0; t < nt; t += 2) {
            const bool last = (t == nt - 2);
            const size_t k1 = (size_t)(t + 1) * kstep, k2 = last ? 0 : (size_t)(t + 2) * kstep, k3 = k2 + kstep;
            const char* a2 = last ? nA : cA; const char* b2 = (last ? nB : cB) + k2; const char* b3 = b2 + kstep;
            unsigned v2[2][2];
            if constexpr (GA) {
                if (last && has_next) S.avoff(ui + 1, nxt, R, C, v2);
                else {
#pragma unroll
                    for (int h = 0; h < 2; ++h)
#pragma unroll
                        for (int i = 0; i < 2; ++i) v2[h][i] = cvo[h][i];
                }
            }
            if constexpr (HM) {
            PG8_LDB(B0, 0, 0); PG8_SCHED; PG8_LDA(At, 0, 0); PG8_STAGE(PG8_SB(1, 1), cB + hstep + k1, voffB);
            PG8_WAIT_V(6); PG8_WAIT_L(0); PG8_BAR; PG8_MMA(0, 0, At, B0); PG8_BAR; PG8_SCHED;
            PG8_LDB(B1, 0, 1); PG8_STAGE(PG8_SB(0, 0), b2, voffB); PG8_STAGE_A(PG8_SA(0, 0), a2, v2, 0, k2);
            PG8_WAIT_V(6); PG8_WAIT_L(0); PG8_BAR; PG8_MMA(0, 1, At, B1); PG8_BAR; PG8_SCHED;
            PG8_LDB(B0, 1, 0); PG8_SCHED; PG8_LDA(At, 1, 0); PG8_STAGE(PG8_SB(0, 1), b2 + hstep, voffB);
            PG8_WAIT_V(6); PG8_WAIT_L(0); PG8_BAR; PG8_MMA(0, 0, At, B0); PG8_BAR; PG8_SCHED;
            PG8_LDB(B1, 1, 1); PG8_STAGE(PG8_SB(1, 0), b3, voffB); PG8_STAGE_A(PG8_SA(1, 0), a2, v2, 0, k3);
            PG8_WAIT_V(6); PG8_WAIT_L(0); PG8_BAR; PG8_MMA(0, 1, At, B1); PG8_BAR; PG8_SCHED;
            } else if constexpr (Sched::FP8) {
#define F8_KTILE(b, sB0n, aX, vX, kX, sB1x, zc) \
            PG8_LDB(B0, b, 0); PG8_SCHED; PG8_LDA(At, b, 0); PG8_STAGE(PG8_SB(1 - (b), 0), sB0n, voffB); \
            PG8_WAIT_V(12); PG8_WAIT_L(0); PG8_BAR; PG8_MMAZ(0, 0, At, B0, zc); PG8_BAR; PG8_SCHED; \
            PG8_LDB(B1, b, 1); PG8_STAGE_A(PG8_SA(b, 0), aX, vX, 0, kX); \
            PG8_WAIT_V(12); PG8_WAIT_L(0); PG8_BAR; PG8_MMAZ(0, 1, At, B1, zc); PG8_BAR; PG8_SCHED; \
            PG8_LDA(At, b, 1); PG8_STAGE(PG8_SB(b, 1), sB1x, voffB); \
            PG8_WAIT_V(12); PG8_WAIT_L(0); PG8_BAR; PG8_MMAZ(1, 1, At, B1, zc); PG8_BAR; PG8_SCHED; \
            PG8_LDB(B0, b, 0); PG8_STAGE_A(PG8_SA(b, 1), aX, vX, 1, kX); \
            PG8_WAIT_V(6); PG8_WAIT_L(0); PG8_BAR; PG8_MMAZ(1, 0, At, B0, zc); PG8_BAR; PG8_SCHED;
            F8_KTILE(0, cB + k1, a2, v2, k2, b2 + hstep, (t == 0))
            F8_KTILE(1, b2, a2, v2, k3, b3 + hstep, false)
#undef F8_KTILE
            } else {
            PG8_LDB(B0, 0, 0); PG8_LDB(B1, 0, 1); PG8_SCHED; PG8_LDA(At, 0, 0); PG8_STAGE_A(PG8_SA(1, 1), cA, cvo, 1, k1);
            PG8_WAIT_V(8); PG8_WAIT_L(0); PG8_BAR; PG8_MMA(0, 0, At, B0); PG8_MMA(0, 1, At, B1); PG8_BAR; PG8_SCHED;
            PG8_LDA(At, 0, 1); PG8_STAGE(PG8_SB(0, 0), b2, voffB); PG8_STAGE(PG8_SB(0, 1), b2 + hstep, voffB); PG8_STAGE_A(PG8_SA(0, 0), a2, v2, 0, k2);
            PG8_WAIT_V(8); PG8_WAIT_L(0); PG8_BAR; PG8_MMA(1, 0, At, B0); PG8_MMA(1, 1, At, B1); PG8_BAR; PG8_SCHED;
            PG8_LDB(B0, 1, 0); PG8_LDB(B1, 1, 1); PG8_SCHED; PG8_LDA(At, 1, 0); PG8_STAGE_A(PG8_SA(0, 1), a2, v2, 1, k2);
            PG8_WAIT_V(8); PG8_WAIT_L(0); PG8_BAR; PG8_MMA(0, 0, At, B0); PG8_MMA(0, 1, At, B1); PG8_BAR; PG8_SCHED;
            PG8_LDA(At, 1, 1); PG8_STAGE(PG8_SB(1, 0), b3, voffB); PG8_STAGE(PG8_SB(1, 1), b3 + hstep, voffB); PG8_STAGE_A(PG8_SA(1, 0), a2, v2, 0, k3);
            PG8_WAIT_V(8); PG8_WAIT_L(0); PG8_BAR; PG8_MMA(1, 0, At, B0); PG8_MMA(1, 1, At, B1); PG8_BAR; PG8_SCHED;
            }
            if constexpr (GA) { if (last) {
#pragma unroll
                for (int h = 0; h < 2; ++h)
#pragma unroll
                    for (int i = 0; i < 2; ++i) cvo[h][i] = v2[h][i]; } }
        }
        if (wr == 0) PG8_BAR;
        { const int l2_ = tid_() & 63; E(acc, cur, wr, wc, l2_ & 15, l2_ >> 4); }
#ifdef MK_EPI2
        E(acc, cur, wr, wc, fr, fq);
#endif
        if (!has_next) break;
        if constexpr (!(Sched::FP8 && !HM)) {
#pragma unroll
        for (int a = 0; a < 2; ++a)
#pragma unroll
            for (int b = 0; b < 2; ++b)
#pragma unroll
                for (int m = 0; m < 4; ++m)
#pragma unroll
                    for (int n = 0; n < 2; ++n) acc[a][b][m][n] = (f32x4){0.f, 0.f, 0.f, 0.f};
        }
        cur = nxt; cB = nB; cA = nA; ++ui;
        if (wr == 1) PG8_BAR;
    }
    PG8_WAIT_V(0);
    PG8_BAR;
#undef PG8_SA
#undef PG8_SB
#undef PG8_STAGE
#undef PG8_STAGE_A
#undef PG8_LDA
#undef PG8_LDB
#undef PG8_MMA
#undef PG8_MMAZ
#undef PG8_WAIT_V
#undef PG8_WAIT_L
#undef PG8_BAR
#undef PG8_SCHED
}

#define EPI_LOOP_BEGIN \
    _Pragma("unroll") for (int bj = 0; bj < 2; ++bj) { const int c0 = u.col0 + bj * HALF + wc * 32 + 8 * fq; (void)c0;
#define EPI_ROWS_BEGIN \
    _Pragma("unroll") for (int ai = 0; ai < NAI; ++ai) _Pragma("unroll") for (int m = 0; m < 4; ++m) { const int lr = ai * HALF + wr * 64 + m * 16 + fr; const int row = u.row0 + lr; (void)row; \
        float v[8]; { const f32x4 v0 = acc[ai][bj][m][0], v1 = acc[ai][bj][m][1]; v[0] = v0[0]; v[1] = v0[1]; v[2] = v0[2]; v[3] = v0[3]; v[4] = v1[0]; v[5] = v1[1]; v[6] = v1[2]; v[7] = v1[3]; }
#define EPI_END } }

template <bool HM_ = false> struct EpiBf16 {
    static constexpr int NAI = HM_ ? 1 : 2;
    bf16_t* O; int ld, ncols; float sc;
    DI void operator()(const f32x4 (&acc)[2][2][4][2], const Unit& u, int wr, int wc, int fr, int fq) const {
        EPI_LOOP_BEGIN
            if (c0 < ncols) {
        EPI_ROWS_BEGIN
                u32x4 w; w.x = pk(v[0] * sc, v[1] * sc); w.y = pk(v[2] * sc, v[3] * sc); w.z = pk(v[4] * sc, v[5] * sc); w.w = pk(v[6] * sc, v[7] * sc);
                *(u32x4*)(O + (size_t)row * ld + c0) = w;
            } }
        }
    }
};
struct EpiF32 {
    static constexpr int NAI = 2;
    float* O; int ld, ncols;
    DI void operator()(const f32x4 (&acc)[2][2][4][2], const Unit& u, int wr, int wc, int fr, int fq) const {
        EPI_LOOP_BEGIN
            if (c0 < ncols) {
        EPI_ROWS_BEGIN
                float* p = O + (size_t)row * ld + c0;
                *(f32x4*)p = (f32x4){v[0], v[1], v[2], v[3]}; *(f32x4*)(p + 4) = (f32x4){v[4], v[5], v[6], v[7]};
            } }
        }
    }
};
struct EpiHgIn {
    static constexpr int NAI = 2;
    bf16_t* P; const float* lb; float sc;
    DI void operator()(const f32x4 (&acc)[2][2][4][2], const Unit& u, int wr, int wc, int fr, int fq) const {
        const int sec = u.col0 >> 11;
        EPI_LOOP_BEGIN
            float lbv[8];
#pragma unroll
            for (int j = 0; j < 8; ++j) lbv[j] = 0.f;
            if (sec == 1 || sec == 2) { const float* lp = lb + (sec - 1) * 2048 + (c0 & 2047); const f32x4 l0 = *(const f32x4*)lp, l1 = *(const f32x4*)(lp + 4);
                lbv[0] = l0[0]; lbv[1] = l0[1]; lbv[2] = l0[2]; lbv[3] = l0[3]; lbv[4] = l1[0]; lbv[5] = l1[1]; lbv[6] = l1[2]; lbv[7] = l1[3]; }
        EPI_ROWS_BEGIN
#pragma unroll
            for (int j = 0; j < 8; ++j) v[j] *= sc;
            if (sec == 0 || sec == 4) {
#pragma unroll
                for (int j = 0; j < 8; ++j) v[j] = v[j] * sigm(v[j]);
            } else if (sec == 1 || sec == 2) {
#pragma unroll
                for (int j = 0; j < 8; ++j) v[j] = __logf(lbv[j] + (1.0f - lbv[j]) * sigm(v[j]));
            }
            u32x4 w; w.x = pk(v[0], v[1]); w.y = pk(v[2], v[3]); w.z = pk(v[4], v[5]); w.w = pk(v[6], v[7]);
            *(u32x4*)(P + (size_t)row * HGN + c0) = w;
        EPI_END
    }
};
template <bool HM_, bool ACT8_ = HM_> struct EpiGU {
    static constexpr int NAI = HM_ ? 1 : 2;
    bf16_t* act; const float* bgu; float sc;
    DI void operator()(const f32x4 (&acc)[2][2][4][2], const Unit& u, int wr, int wc, int fr, int fq) const {
        EPI_LOOP_BEGIN
            const float* bp = bgu + (size_t)u.e * 4096 + c0; const f32x4 b0 = *(const f32x4*)bp, b1 = *(const f32x4*)(bp + 4);
        EPI_ROWS_BEGIN
            const float x0 = fminf(v[0] * sc + b0[0], 7.f), l0 = fminf(fmaxf(v[1] * sc + b0[1], -7.f), 7.f);
            const float x1 = fminf(v[2] * sc + b0[2], 7.f), l1 = fminf(fmaxf(v[3] * sc + b0[3], -7.f), 7.f);
            const float x2 = fminf(v[4] * sc + b1[0], 7.f), l2 = fminf(fmaxf(v[5] * sc + b1[1], -7.f), 7.f);
            const float x3 = fminf(v[6] * sc + b1[2], 7.f), l3 = fminf(fmaxf(v[7] * sc + b1[3], -7.f), 7.f);
            const float a0 = x0 * sigm(1.702f * x0) * (l0 + 1.f), a1 = x1 * sigm(1.702f * x1) * (l1 + 1.f);
            const float a2 = x2 * sigm(1.702f * x2) * (l2 + 1.f), a3 = x3 * sigm(1.702f * x3) * (l3 + 1.f);
            if constexpr (ACT8_) *(unsigned*)((unsigned char*)act + (size_t)row * 2048 + (c0 >> 1)) = pk8(a0 * F8_ACTSCALE, a1 * F8_ACTSCALE, a2 * F8_ACTSCALE, a3 * F8_ACTSCALE);
            else { u32x2 w; w.x = pk(a0, a1); w.y = pk(a2, a3); *(u32x2*)(act + (size_t)row * 2048 + (c0 >> 1)) = w; }
        EPI_END
    }
};
template <bool HM_> struct EpiDN {
    static constexpr int NAI = HM_ ? 1 : 2;
    bf16_t* y2; const float* bdn; const float* lgate; const LAS int* cn; float sc;
    DI void operator()(const f32x4 (&acc)[2][2][4][2], const Unit& u, int wr, int wc, int fr, int fq) const {
        const int cnt = cn[u.e];
        EPI_LOOP_BEGIN
            const float* bp = bdn + (size_t)u.e * 2048 + c0; const f32x4 b0 = *(const f32x4*)bp, b1 = *(const f32x4*)(bp + 4);
        EPI_ROWS_BEGIN
            const int slot = u.aux + lr;
            const float g = slot < cnt ? lgate[(size_t)u.e * TCAP + slot] : 0.f;
            u32x4 w; w.x = pk((v[0] * sc + b0[0]) * g, (v[1] * sc + b0[1]) * g); w.y = pk((v[2] * sc + b0[2]) * g, (v[3] * sc + b0[3]) * g);
            w.z = pk((v[4] * sc + b1[0]) * g, (v[5] * sc + b1[1]) * g); w.w = pk((v[6] * sc + b1[2]) * g, (v[7] * sc + b1[3]) * g);
            *(u32x4*)(y2 + (size_t)row * 2048 + c0) = w;
        EPI_END
    }
};
}

struct Args { const float* in[24]; float* out; unsigned char* ws; int ph_lo, ph_hi; };
enum { I_X = 0, I_C, I_CTX, I_CCTX, I_ADAW, I_ADAB, I_LNG, I_LNB, I_HGWIN, I_HGGN, I_HGLB, I_HGWO, I_MWIN, I_MQN, I_MKVN, I_MWUQ, I_MWUKV, I_MWO, I_RW, I_RB, I_WGU, I_BGU, I_WDN, I_BDN };

namespace cvq {
constexpr int E0 = 1280, E1 = 1536, E2 = 17920, E3 = 26112, E4 = 26256, E5 = 26352, E6 = 26480, E7 = 26736, E8 = 43120, TOTAL = 51312, BATCH = 8;
constexpr int CV_NEXT = 8192, CV_DONE0 = 8256;
DI int need(int p) { return p < 2 ? 0 : p < 5 ? E0 : p < 7 ? E1 : p < 8 ? E2 : p < 10 ? E3 : p < 12 ? E4 : p < 14 ? E6 : p < 16 ? E7 : p < 17 ? E8 : TOTAL; }
struct Tile { const float* sp; bf16_t* dp; int K, N, ncol0, f8; };
DI void decode(const Args& a, int t, Tile& x) {
    unsigned char* ws = a.ws;
    const float* src; bf16_t* dst; int K, N, nmat_per; size_t ss, ds; int loc; int f8 = 0;
    if (t < E0)      { src = a.in[I_HGWIN]; dst = (bf16_t*)(ws + WS_WHGIN); K = 2048; N = HGN;  ss = 0; ds = 0; loc = t; f8 = 1; }
    else if (t < E1) { src = a.in[I_HGWO];  dst = (bf16_t*)(ws + WS_WHGO);  K = 2048; N = 2048; ss = 0; ds = 0; loc = t - E0; f8 = 2; }
    else if (t < E2) { src = a.in[I_WGU];   dst = (bf16_t*)(ws + WS_WGU);   K = 2048; N = 4096; ss = (size_t)2048 * 4096; ds = ss; loc = t - E1; f8 = 1; }
    else if (t < E3) { src = a.in[I_WDN];   dst = (bf16_t*)(ws + WS_WDN);   K = 2048; N = 2048; ss = (size_t)2048 * 2048; ds = ss; loc = t - E2; f8 = 2; }
    else if (t < E4) { src = a.in[I_MWIN];  dst = (bf16_t*)(ws + WS_WMIN);  K = 2048; N = 1088; ss = 0; ds = 0; loc = t - E3; }
    else if (t < E5) { src = a.in[I_MWUQ];  dst = (bf16_t*)(ws + WS_WUQ);   K = 512;  N = 3072; ss = 0; ds = 0; loc = t - E4; }
    else if (t < E6) { src = a.in[I_MWUKV]; dst = (bf16_t*)(ws + WS_WUKV);  K = 512;  N = 4096; ss = 0; ds = 0; loc = t - E5; }
    else if (t < E7) { src = a.in[I_MWO];   dst = (bf16_t*)(ws + WS_WMO);   K = 2048; N = 2048; ss = 0; ds = 0; loc = t - E6; f8 = 2; }
    else if (t < E8) { src = a.in[I_WGU] + (size_t)32 * 2048 * 4096; dst = (bf16_t*)(ws + WS_WGU) + (size_t)32 * 2048 * 4096; K = 2048; N = 4096; ss = (size_t)2048 * 4096; ds = ss; loc = t - E7; f8 = 1; }
    else             { src = a.in[I_WDN] + (size_t)32 * 2048 * 2048; dst = (bf16_t*)(ws + WS_WDN) + (size_t)32 * 2048 * 2048; K = 2048; N = 2048; ss = (size_t)2048 * 2048; ds = ss; loc = t - E8; f8 = 2; }
    (void)nmat_per;
    const int ntiles = (N + 127) / 128, ktiles = K / 128, per = ktiles * ntiles, mat = loc / per, rem = loc - mat * per, ntl = rem / ktiles, kt = rem - ntl * ktiles;
    x.K = K; x.N = N; x.ncol0 = ntl * 128;
    x.sp = src + (size_t)mat * ss + (size_t)(kt * 128) * N + ntl * 128;
    x.dp = dst + (size_t)mat * ds + (size_t)(ntl * 128) * K + kt * 128; x.f8 = f8;
    if (f8) x.dp = (bf16_t*)((unsigned char*)dst + (size_t)mat * ds + (size_t)(ntl * 128) * K + kt * 128);
}
DI void load_tile(const Tile& x, int n4, int kr, f32x4 (&rg)[8]) {
    int nc = n4 * 4; { const int lim = x.N - x.ncol0 - 4; nc = nc < lim ? nc : lim; }
    const float* sp = x.sp + (size_t)kr * x.N + nc;
#pragma unroll
    for (int i = 0; i < 8; ++i) rg[i] = __builtin_nontemporal_load((const f32x4*)(sp + (size_t)(16 * i) * x.N));
}
DI void out_tile(const Tile& cur, LAS float* tile, int k8, int ng) {
    f32x4 v[8];
#pragma unroll
    for (int i = 0; i < 8; ++i) v[i] = *(const LAS f32x4*)(tile + (8 * k8 + i) * 128 + 4 * (ng ^ k8));
    if (cur.f8) {
        unsigned char* dp = (unsigned char*)cur.dp + (size_t)(4 * ng) * cur.K + 8 * k8; const float ws_ = cur.f8 == 1 ? F8_WSCALE : F8_WSCALE_DN;
#pragma unroll
        for (int j = 0; j < 4; ++j) {
            u32x2 w; w.x = pk8(v[0][j] * ws_, v[1][j] * ws_, v[2][j] * ws_, v[3][j] * ws_); w.y = pk8(v[4][j] * ws_, v[5][j] * ws_, v[6][j] * ws_, v[7][j] * ws_);
            __builtin_nontemporal_store(w, (u32x2*)(dp + (size_t)j * cur.K));
        }
    } else if (cur.ncol0 + 4 * ng < cur.N) {
        bf16_t* dp = cur.dp + (size_t)(4 * ng) * cur.K + 8 * k8;
#pragma unroll
        for (int j = 0; j < 4; ++j) {
            u32x4 w; w.x = pk(v[0][j], v[1][j]); w.y = pk(v[2][j], v[3][j]); w.z = pk(v[4][j], v[5][j]); w.w = pk(v[6][j], v[7][j]);
            __builtin_nontemporal_store(w, (u32x4*)(dp + (size_t)j * cur.K));
        }
    }
}
DI void batch(const Args& a, int t0, LAS unsigned char* lds) {
    constexpr int nb = BATCH;
    LAS float* tile = (LAS float*)lds;
    const int tid = tid_(), n4 = tid & 31, kr = tid >> 5, k8 = tid & 15, ng = tid >> 4;
    f32x4 rgA[8], rgB[8]; Tile tA, tB, tn;
    decode(a, t0, tA); load_tile(tA, n4, kr, rgA);
    decode(a, t0 + 1, tB); load_tile(tB, n4, kr, rgB);
#define CV_PUT(RG) _Pragma("unroll") for (int i = 0; i < 8; ++i) *(LAS f32x4*)(tile + (kr + 16 * i) * 128 + 4 * (n4 ^ (((kr >> 3) + 2 * i) & 15))) = RG[i]
#pragma unroll
    for (int j = 0; j < nb; j += 2) {
        CV_PUT(rgA);
        __syncthreads();
        if (j + 2 < nb) { decode(a, t0 + j + 2, tn); load_tile(tn, n4, kr, rgA); }
        out_tile(tA, tile, k8, ng);
        __syncthreads();
        tA = tn;
        CV_PUT(rgB);
        __syncthreads();
        if (j + 3 < nb) { decode(a, t0 + j + 3, tn); load_tile(tn, n4, kr, rgB); }
        out_tile(tB, tile, k8, ng);
        __syncthreads();
        tB = tn;
    }
#undef CV_PUT
}
DI void service(const Args& a, LAS unsigned char* lds, int mandatory, unsigned* done_word, unsigned done_target) {
    unsigned* nextw = (unsigned*)(a.ws + WS_CTL) + CV_NEXT;
    volatile LAS int* slot = (volatile LAS int*)(lds + LCTL_OFF + 512);
    for (;;) {
        __syncthreads();
        if (threadIdx.x == 0) {
            int t0 = -1; const unsigned curv = __hip_atomic_load(nextw, __ATOMIC_RELAXED, __HIP_MEMORY_SCOPE_AGENT);
            bool go = curv < (unsigned)TOTAL && (curv < (unsigned)mandatory || (done_word != nullptr && __hip_atomic_load(done_word, __ATOMIC_RELAXED, __HIP_MEMORY_SCOPE_AGENT) < done_target));
            if (go) { t0 = (int)__hip_atomic_fetch_add(nextw, (unsigned)BATCH, __ATOMIC_RELAXED, __HIP_MEMORY_SCOPE_AGENT); if (t0 >= TOTAL) t0 = -1; }
            slot[0] = t0;
        }
        __syncthreads();
        const int t0 = slot[0];
        if (t0 < 0) break;
        batch(a, t0, lds);
    }
}
DI void signal_done(const Args& a, int p) {
    asm volatile("s_waitcnt vmcnt(0)" ::: "memory"); __syncthreads();
    if (threadIdx.x == 0) __hip_atomic_fetch_add((unsigned*)(a.ws + WS_CTL) + CV_DONE0 + 64 * p, 1u, __ATOMIC_RELAXED, __HIP_MEMORY_SCOPE_AGENT);
}
DI unsigned* done_word(const Args& a, int p) { return (unsigned*)(a.ws + WS_CTL) + CV_DONE0 + 64 * p; }
}

DI void p0_prologue(const Args& a, LAS unsigned char* lds, int G) {
    const int tid = tid_();
    unsigned char* ws = a.ws;
    if ((int)blockIdx.x < 192) {
        LAS float* sc = (LAS float*)lds;
        LAS float* red = (LAS float*)(lds + 40960);
        for (int idx = tid; idx < 5 * 2048; idx += 512) { const int r = idx >> 11, k = idx & 2047; const float v = r < 4 ? a.in[I_C][r * 2048 + k] : a.in[I_CCTX][k]; sc[idx] = v * sigm(v); }
        __syncthreads();
        float* modv = (float*)(ws + WS_MODV);
        for (int u = blockIdx.x; u < 192; u += G) {
            const int l = u / 96, n0 = (u % 96) * 128, cg = tid & 31, kq = tid >> 5;
            f32x4 ac[5];
#pragma unroll
            for (int r = 0; r < 5; ++r) ac[r] = (f32x4){0.f, 0.f, 0.f, 0.f};
            const float* wp = a.in[I_ADAW] + ((size_t)l * 2048 + kq * 128) * NMOD + n0 + cg * 4;
#pragma unroll 8
            for (int kk = 0; kk < 128; ++kk) {
                const f32x4 w = *(const f32x4*)(wp + (size_t)kk * NMOD);
#pragma unroll
                for (int r = 0; r < 5; ++r) { const float s = sc[r * 2048 + kq * 128 + kk]; ac[r] += s * w; }
            }
#pragma unroll
            for (int r = 0; r < 5; ++r) *(LAS f32x4*)(red + (kq * 5 + r) * 128 + cg * 4) = ac[r];
            __syncthreads();
            for (int idx = tid; idx < 640; idx += 512) { const int r = idx >> 7, n = idx & 127; float s = a.in[I_ADAB][l * NMOD + n0 + n];
                for (int q = 0; q < 16; ++q) s += red[(q * 5 + r) * 128 + n];
                modv[((size_t)l * 5 + r) * NMOD + n0 + n] = s; }
            __syncthreads();
        }
    }
    if ((int)blockIdx.x == G - 1) {
        float* lb = (float*)(ws + WS_LB); float* cs = (float*)(ws + WS_ROPE);
        for (int idx = tid; idx < 4096; idx += 512) {
            const float l0 = a.in[I_HGLB][idx], l1 = a.in[I_HGLB][4096 + idx], l2 = a.in[I_HGLB][8192 + idx];
            const float mx = fmaxf(l0, fmaxf(l1, l2)); const float e0 = expf(l0 - mx), e1 = expf(l1 - mx), e2 = expf(l2 - mx);
            lb[idx] = e0 / (e0 + e1 + e2);
        }
        for (int idx = tid; idx < 1024; idx += 512) { const int pos = idx >> 4, i = idx & 15; const float fr = powf(10000.0f, -(float)i / 16.0f); const float ang = (float)pos * fr;
            cs[idx * 2] = cosf(ang); cs[idx * 2 + 1] = sinf(ang); }
    }
    __syncthreads();
}

DI void ph_modulate(const float* xl, const float* xc, const float* modl  , int jshift, int jscale, bf16_t* hout, int G) {
    const int tid = tid_(); const int lane = tid & 63, wv = __builtin_amdgcn_readfirstlane(tid >> 6);
    for (int row = blockIdx.x * 8 + wv; row < T; row += G * 8) {
        const float* xp = row < TL ? xl + (size_t)row * DM : xc + (size_t)(row - TL) * DM;
        const float* mp = modl + (size_t)(row < TL ? (row >> 12) : 4) * NMOD;
        f32x4 x[8]; float s = 0.f;
#pragma unroll
        for (int i = 0; i < 8; ++i) { x[i] = *(const f32x4*)(xp + (i * 64 + lane) * 4); s += (x[i][0] + x[i][1]) + (x[i][2] + x[i][3]); }
        const float mean = wave_sum(s) * (1.0f / DM); float q = 0.f;
#pragma unroll
        for (int i = 0; i < 8; ++i) { const f32x4 d = x[i] - mean; q += (d[0] * d[0] + d[1] * d[1]) + (d[2] * d[2] + d[3] * d[3]); }
        const float rstd = rsqrtf(wave_sum(q) * (1.0f / DM) + LN_EPS);
#pragma unroll
        for (int i = 0; i < 8; ++i) { const int d0 = (i * 64 + lane) * 4; const f32x4 sh = *(const f32x4*)(mp + jshift * DM + d0), sc = *(const f32x4*)(mp + jscale * DM + d0);
            const f32x4 hv = (x[i] - mean) * rstd * (1.0f + sc) + sh;
            *(unsigned*)((unsigned char*)hout + (size_t)row * DM + d0) = pk8(clamp8(hv[0] * F8_ASCALE), clamp8(hv[1] * F8_ASCALE), clamp8(hv[2] * F8_ASCALE), clamp8(hv[3] * F8_ASCALE)); }
    }
}

DI void ph_hg_combine(const Args& a, int G) {
    const bf16_t* of = (const bf16_t*)(a.ws + WS_OF); const bf16_t* ob = (const bf16_t*)(a.ws + WS_OB); const bf16_t* P = (const bf16_t*)(a.ws + WS_P);
    bf16_t* og = (bf16_t*)(a.ws + WS_OG); const float* gn = a.in[I_HGGN];
    const int tid = tid_(); const int lane = tid & 63, wv = __builtin_amdgcn_readfirstlane(tid >> 6);
    for (int row = blockIdx.x * 8 + wv; row < T; row += G * 8) {
        float o[32]; float ss = 0.f;
#pragma unroll
        for (int q = 0; q < 4; ++q) { const u32x4 f = *(const u32x4*)(of + (size_t)row * DM + lane * 32 + q * 8), b = *(const u32x4*)(ob + (size_t)row * DM + lane * 32 + q * 8);
#pragma unroll
            for (int j = 0; j < 4; ++j) { o[q * 8 + 2 * j] = bf_lo(f[j]) + bf_lo(b[j]); o[q * 8 + 2 * j + 1] = bf_hi(f[j]) + bf_hi(b[j]); } }
#pragma unroll
        for (int j = 0; j < 32; ++j) ss += o[j] * o[j];
        ss += __shfl_xor(ss, 1); ss += __shfl_xor(ss, 2);
        const float r = rsqrtf(ss * (1.0f / 128.0f) + RMS_EPS);
#pragma unroll
        for (int q = 0; q < 4; ++q) { const u32x4 g = *(const u32x4*)(P + (size_t)row * HGN + 8192 + lane * 32 + q * 8);
            const f32x4 w0 = *(const f32x4*)(gn + lane * 32 + q * 8), w1 = *(const f32x4*)(gn + lane * 32 + q * 8 + 4);
            float t[8];
#pragma unroll
            for (int j = 0; j < 4; ++j) { t[2 * j] = o[q * 8 + 2 * j] * r * (j < 2 ? w0[2 * j] : w1[2 * j - 4]) * bf_lo(g[j]); t[2 * j + 1] = o[q * 8 + 2 * j + 1] * r * (j < 2 ? w0[2 * j + 1] : w1[2 * j - 3]) * bf_hi(g[j]); }
#pragma unroll
            for (int j = 0; j < 8; ++j) t[j] = clamp8(t[j] * F8_OGSCALE);
            u32x2 w; w.x = pk8(t[0], t[1], t[2], t[3]); w.y = pk8(t[4], t[5], t[6], t[7]);
            *(u32x2*)((unsigned char*)og + (size_t)row * DM + lane * 32 + q * 8) = w; }
    }
}

DI void ph_post_router(const Args& a, int layer, const float* xl, const float* xc, const bf16_t* y, int nrows, LAS unsigned char* lds, int G) {
    unsigned char* ws = a.ws;
    const int tid = tid_(), lane = tid & 63, wv = __builtin_amdgcn_readfirstlane(tid >> 6);
    const float* modl = (const float*)(ws + WS_MODV) + (size_t)layer * 5 * NMOD;
    const float* lng = a.in[I_LNG] + (size_t)(layer * 2 + 0) * DM; const float* lnb = a.in[I_LNB] + (size_t)(layer * 2 + 0) * DM;
    const float* rw = a.in[I_RW] + (size_t)layer * DM * NE; const float* rb = a.in[I_RB] + layer * NE;
    float* x1 = (float*)(ws + WS_X1); bf16_t* h2 = (bf16_t*)(ws + WS_H2);
    unsigned* cnt = (unsigned*)(ws + (layer ? CTL_CNT1 : CTL_CNT0));
    int* ltok = (int*)(ws + WS_LTOK); float* lgate = (float*)(ws + WS_LGATE); unsigned* tokes = (unsigned*)(ws + WS_TOKES);
    LAS float* hs = (LAS float*)lds;
    LAS int* asg_e = (LAS int*)(lds + TAB_OFF); LAS float* asg_g = (LAS float*)(lds + TAB_OFF + 2048); LAS int* asg_s = (LAS int*)(lds + TAB_OFF + 4096);
    LAS int* lc = (LAS int*)(lds + TAB_OFF + 6144); LAS int* lbase = (LAS int*)(lds + TAB_OFF + 6400);
    const int rpb = nrows / G, row0 = blockIdx.x * rpb;
    if (tid < 32) lc[tid] = 0;
    __syncthreads();
    for (int g0 = 0; g0 < rpb; g0 += 16) {
#pragma unroll 1
        for (int rr = 0; rr < 2; ++rr) {
            const int lr = wv * 2 + rr, ri = g0 + lr;
            if (ri < rpb) {
                const int row = row0 + ri;
                const float* xp = row < TL ? xl + (size_t)row * DM : xc + (size_t)(row - TL) * DM;
                const float* mp = modl + (size_t)(row < TL ? (row >> 12) : 4) * NMOD;
                f32x4 z[8]; float s = 0.f;
#pragma unroll
                for (int i = 0; i < 8; ++i) { const int d0 = (i * 64 + lane) * 4; const f32x4 xv = __builtin_nontemporal_load((const f32x4*)(xp + d0)); const u32x2 yv = __builtin_nontemporal_load((const u32x2*)(y + (size_t)row * DM + d0));
                    const f32x4 gt = *(const f32x4*)(mp + 2 * DM + d0); const f32x4 yf = {bf_lo(yv.x), bf_hi(yv.x), bf_lo(yv.y), bf_hi(yv.y)};
                    z[i] = DN_ALPHA * xv + gt * yf; s += (z[i][0] + z[i][1]) + (z[i][2] + z[i][3]); }
                float mean = wave_sum(s) * (1.0f / DM), q = 0.f;
#pragma unroll
                for (int i = 0; i < 8; ++i) { const f32x4 d = z[i] - mean; q += (d[0] * d[0] + d[1] * d[1]) + (d[2] * d[2] + d[3] * d[3]); }
                float rstd = rsqrtf(wave_sum(q) * (1.0f / DM) + LN_EPS);
                s = 0.f;
#pragma unroll
                for (int i = 0; i < 8; ++i) { const int d0 = (i * 64 + lane) * 4; const f32x4 gg = *(const f32x4*)(lng + d0), bb = *(const f32x4*)(lnb + d0);
                    z[i] = (z[i] - mean) * rstd * gg + bb; __builtin_nontemporal_store(z[i], (f32x4*)(x1 + (size_t)row * DM + d0)); s += (z[i][0] + z[i][1]) + (z[i][2] + z[i][3]); }
                mean = wave_sum(s) * (1.0f / DM); q = 0.f;
#pragma unroll
                for (int i = 0; i < 8; ++i) { const f32x4 d = z[i] - mean; q += (d[0] * d[0] + d[1] * d[1]) + (d[2] * d[2] + d[3] * d[3]); }
                rstd = rsqrtf(wave_sum(q) * (1.0f / DM) + LN_EPS);
#pragma unroll
                for (int i = 0; i < 8; ++i) { const int d0 = (i * 64 + lane) * 4; const f32x4 sh = *(const f32x4*)(mp + 3 * DM + d0), sc = *(const f32x4*)(mp + 4 * DM + d0);
                    const f32x4 hv = (z[i] - mean) * rstd * (1.0f + sc) + sh; u32x2 w; w.x = pk(hv[0], hv[1]); w.y = pk(hv[2], hv[3]);
                    if (true) *(unsigned*)((unsigned char*)h2 + (size_t)row * DM + d0) = pk8(clamp8(hv[0] * F8_ASCALE), clamp8(hv[1] * F8_ASCALE), clamp8(hv[2] * F8_ASCALE), clamp8(hv[3] * F8_ASCALE));
                    else *(u32x2*)(h2 + (size_t)row * DM + d0) = w;
                    *(LAS f32x4*)(hs + lr * DM + d0) = hv; }
            }
        }
        __syncthreads();
        {
            LAS float* red = (LAS float*)(lds + TAB_OFF + 8192);
            {
                const int e = tid & 31, rg = (tid >> 5) & 3, dq = tid >> 7;
                float ac[4] = {0.f, 0.f, 0.f, 0.f};
                const LAS float* hp = hs + (4 * rg) * DM + dq * 512; const float* wp = rw + (size_t)(dq * 512) * NE + e;
#pragma unroll 2
                for (int d = 0; d < 512; d += 4) {
                    const float w0 = wp[(d + 0) * NE], w1 = wp[(d + 1) * NE], w2 = wp[(d + 2) * NE], w3 = wp[(d + 3) * NE];
#pragma unroll
                    for (int r = 0; r < 4; ++r) { const f32x4 hv = *(const LAS f32x4*)(hp + r * DM + d); ac[r] += (hv[0] * w0 + hv[1] * w1) + (hv[2] * w2 + hv[3] * w3); }
                }
#pragma unroll
                for (int r = 0; r < 4; ++r) red[(dq * 16 + 4 * rg + r) * 32 + e] = ac[r];
            }
            __syncthreads();
            const int lr = tid >> 5, e = tid & 31, ri = g0 + lr;
            float val = (red[lr * 32 + e] + red[(16 + lr) * 32 + e]) + (red[(32 + lr) * 32 + e] + red[(48 + lr) * 32 + e]) + rb[e];
            float tv[4]; int te[4];
#pragma unroll
            for (int k = 0; k < 4; ++k) {
                float m = val;
#pragma unroll
                for (int o = 16; o >= 1; o >>= 1) m = fmaxf(m, __shfl_xor(m, o));
                int idx = (val == m) ? e : 99;
#pragma unroll
                for (int o = 16; o >= 1; o >>= 1) idx = min(idx, __shfl_xor(idx, o));
                tv[k] = m; te[k] = idx; if (e == idx) val = -3.0e38f;
            }
            if (e == 0 && ri < rpb) {
                const float e1 = __expf(tv[1] - tv[0]), e2 = __expf(tv[2] - tv[0]), e3 = __expf(tv[3] - tv[0]); const float inv = 1.0f / (1.0f + e1 + e2 + e3);
                const float gk[4] = {inv, e1 * inv, e2 * inv, e3 * inv};
#pragma unroll
                for (int k = 0; k < 4; ++k) { const int ai = ri * 4 + k; asg_e[ai] = te[k]; asg_g[ai] = gk[k]; asg_s[ai] = atomicAdd((int*)(lc + te[k]), 1); }
            }
        }
        __syncthreads();
    }
    if (tid < 32) lbase[tid] = (int)__hip_atomic_fetch_add(cnt + tid * 64, (unsigned)lc[tid], __ATOMIC_RELAXED, __HIP_MEMORY_SCOPE_AGENT);
    __syncthreads();
    for (int ai = tid; ai < rpb * 4; ai += 512) {
        const int row = row0 + (ai >> 2), e = asg_e[ai], slot = lbase[e] + asg_s[ai];
        ltok[(size_t)e * TCAP + slot] = row; lgate[(size_t)e * TCAP + slot] = asg_g[ai]; tokes[(size_t)row * 4 + (ai & 3)] = ((unsigned)slot << 5) | (unsigned)e;
    }
    __syncthreads();
}

DI void moe_setup(const Args& a, int layer, LAS unsigned char* lds) {
    LAS int* tb = (LAS int*)(lds + LCTL_OFF + 64); LAS int* cn = (LAS int*)(lds + LCTL_OFF + 256);
    unsigned* cnt = (unsigned*)(a.ws + (layer ? CTL_CNT1 : CTL_CNT0));
    __syncthreads();
    if (threadIdx.x < 32) cn[threadIdx.x] = (int)__hip_atomic_load(cnt + threadIdx.x * 64, __ATOMIC_RELAXED, __HIP_MEMORY_SCOPE_AGENT);
    __syncthreads();
    if (threadIdx.x == 0) { int s = 0; for (int e = 0; e < 32; ++e) { tb[e] = s; s += (cn[e] + 255) >> 8; } tb[32] = s; }
    if (threadIdx.x == 64) { LAS int* th = (LAS int*)(lds + LCTL_OFF + 640); int s = 0; for (int e = 0; e < 32; ++e) { th[e] = s; s += (cn[e] + 127) >> 7; } th[32] = s; }
    __syncthreads();
}

DI void ph_post_ffn(const Args& a, int layer, int nrows, float* outp, bool next_mod, LAS unsigned char* lds, int G) {
    unsigned char* ws = a.ws;
    moe_setup(a, layer, lds);
    const LAS int* tb = (const LAS int*)(lds + LCTL_OFF + 64);
    const int tid = tid_(); const int lane = tid & 63, wv = __builtin_amdgcn_readfirstlane(tid >> 6);
    const float* modl = (const float*)(ws + WS_MODV) + (size_t)layer * 5 * NMOD;
    const float* modn = (const float*)(ws + WS_MODV) + (size_t)(layer + 1) * 5 * NMOD;
    const float* lng = a.in[I_LNG] + (size_t)(layer * 2 + 1) * DM; const float* lnb = a.in[I_LNB] + (size_t)(layer * 2 + 1) * DM;
    const float* x1 = (const float*)(ws + WS_X1); const bf16_t* y2 = (const bf16_t*)(ws + WS_Y2); const unsigned* tokes = (const unsigned*)(ws + WS_TOKES);
    bf16_t* hn = (bf16_t*)(ws + WS_H);
    for (int row = blockIdx.x * 8 + wv; row < nrows; row += G * 8) {
        const int rsel = row < TL ? (row >> 12) : 4;
        const float* mp = modl + (size_t)rsel * NMOD;
        size_t pr[4];
#pragma unroll
        for (int k = 0; k < 4; ++k) { const unsigned es = tokes[(size_t)row * 4 + k]; const int e = es & 31, slot = es >> 5; pr[k] = ((size_t)tb[e] * 256 + slot) * DM; }
        f32x4 z[8]; float s = 0.f;
#pragma unroll
        for (int i = 0; i < 8; ++i) { const int d0 = (i * 64 + lane) * 4; f32x4 ys = {0.f, 0.f, 0.f, 0.f};
#pragma unroll
            for (int k = 0; k < 4; ++k) { const u32x2 yv = __builtin_nontemporal_load((const u32x2*)(y2 + pr[k] + d0)); ys += (f32x4){bf_lo(yv.x), bf_hi(yv.x), bf_lo(yv.y), bf_hi(yv.y)}; }
            const f32x4 xv = __builtin_nontemporal_load((const f32x4*)(x1 + (size_t)row * DM + d0)), gt = *(const f32x4*)(mp + 5 * DM + d0);
            z[i] = DN_ALPHA * xv + gt * ys; s += (z[i][0] + z[i][1]) + (z[i][2] + z[i][3]); }
        float mean = wave_sum(s) * (1.0f / DM), q = 0.f;
#pragma unroll
        for (int i = 0; i < 8; ++i) { const f32x4 d = z[i] - mean; q += (d[0] * d[0] + d[1] * d[1]) + (d[2] * d[2] + d[3] * d[3]); }
        float rstd = rsqrtf(wave_sum(q) * (1.0f / DM) + LN_EPS);
        s = 0.f;
#pragma unroll
        for (int i = 0; i < 8; ++i) { const int d0 = (i * 64 + lane) * 4; const f32x4 gg = *(const f32x4*)(lng + d0), bb = *(const f32x4*)(lnb + d0);
            z[i] = (z[i] - mean) * rstd * gg + bb; __builtin_nontemporal_store(z[i], (f32x4*)(outp + (size_t)row * DM + d0)); s += (z[i][0] + z[i][1]) + (z[i][2] + z[i][3]); }
        if (next_mod) {
            const float* mq = modn + (size_t)rsel * NMOD;
            mean = wave_sum(s) * (1.0f / DM); q = 0.f;
#pragma unroll
            for (int i = 0; i < 8; ++i) { const f32x4 d = z[i] - mean; q += (d[0] * d[0] + d[1] * d[1]) + (d[2] * d[2] + d[3] * d[3]); }
            rstd = rsqrtf(wave_sum(q) * (1.0f / DM) + LN_EPS);
#pragma unroll
            for (int i = 0; i < 8; ++i) { const int d0 = (i * 64 + lane) * 4; const f32x4 sh = *(const f32x4*)(mq + 0 * DM + d0), sc = *(const f32x4*)(mq + 1 * DM + d0);
                const f32x4 hv = (z[i] - mean) * rstd * (1.0f + sc) + sh; u32x2 w; w.x = pk(hv[0], hv[1]); w.y = pk(hv[2], hv[3]);
                *(u32x2*)(hn + (size_t)row * DM + d0) = w; }
        }
    }
}

DI void ph_mla_local(const Args& a, int G) {
    unsigned char* ws = a.ws;
    const float* pm = (const float*)(ws + WS_PM); bf16_t* cqn = (bf16_t*)(ws + WS_CQN); bf16_t* ckvn = (bf16_t*)(ws + WS_CKVN); bf16_t* kp = (bf16_t*)(ws + WS_KP);
    const float* cs = (const float*)(ws + WS_ROPE); const float* qw = a.in[I_MQN]; const float* kw = a.in[I_MKVN];
    const int tid = tid_(); const int lane = tid & 63, wv = __builtin_amdgcn_readfirstlane(tid >> 6);
    for (int row = blockIdx.x * 8 + wv; row < T; row += G * 8) {
        const float* pp = pm + (size_t)row * 1088;
        {   const f32x4 c0 = *(const f32x4*)(pp + 512 + lane * 8), c1 = *(const f32x4*)(pp + 512 + lane * 8 + 4);
            float ss = (c0[0] * c0[0] + c0[1] * c0[1]) + (c0[2] * c0[2] + c0[3] * c0[3]) + (c1[0] * c1[0] + c1[1] * c1[1]) + (c1[2] * c1[2] + c1[3] * c1[3]);
            const float r = rsqrtf(wave_sum(ss) * (1.0f / 512.0f) + RMS_EPS);
            const f32x4 w0 = *(const f32x4*)(kw + lane * 8), w1 = *(const f32x4*)(kw + lane * 8 + 4);
            u32x4 w; w.x = pk(c0[0] * r * w0[0], c0[1] * r * w0[1]); w.y = pk(c0[2] * r * w0[2], c0[3] * r * w0[3]); w.z = pk(c1[0] * r * w1[0], c1[1] * r * w1[1]); w.w = pk(c1[2] * r * w1[2], c1[3] * r * w1[3]);
            *(u32x4*)(ckvn + (size_t)row * 512 + lane * 8) = w; }
        if (row < TL) {
            const f32x4 c0 = *(const f32x4*)(pp + lane * 8), c1 = *(const f32x4*)(pp + lane * 8 + 4);
            float ss = (c0[0] * c0[0] + c0[1] * c0[1]) + (c0[2] * c0[2] + c0[3] * c0[3]) + (c1[0] * c1[0] + c1[1] * c1[1]) + (c1[2] * c1[2] + c1[3] * c1[3]);
            const float r = rsqrtf(wave_sum(ss) * (1.0f / 512.0f) + RMS_EPS);
            const f32x4 w0 = *(const f32x4*)(qw + lane * 8), w1 = *(const f32x4*)(qw + lane * 8 + 4);
            u32x4 w; w.x = pk(c0[0] * r * w0[0], c0[1] * r * w0[1]); w.y = pk(c0[2] * r * w0[2], c0[3] * r * w0[3]); w.z = pk(c1[0] * r * w1[0], c1[1] * r * w1[1]); w.w = pk(c1[2] * r * w1[2], c1[3] * r * w1[3]);
            *(u32x4*)(cqn + (size_t)row * 512 + lane * 8) = w;
        }
        if (lane < 32) {
            const int i = lane & 15, half = lane >> 4;
            const float xa = pp[1024 + 32 * half + i], xb = pp[1024 + 32 * half + 16 + i];
            float oa = xa, ob = xb;
            if (row < TL) { const int s = row & (SEQ - 1); const int pos = half ? (s & 63) : (s >> 6); const float c = cs[(pos * 16 + i) * 2], sn = cs[(pos * 16 + i) * 2 + 1];
                oa = xa * c - xb * sn; ob = xa * sn + xb * c; }
            const unsigned wa = pk(oa, 0.f), wb = pk(ob, 0.f);
            kp[(size_t)row * 64 + 32 * half + i] = (bf16_t)(wa & 0xffffu); kp[(size_t)row * 64 + 32 * half + 16 + i] = (bf16_t)(wb & 0xffffu);
        }
    }
}

namespace hg {
constexpr int QH_OFF = 0, QT_OFF = 8704, KT_OFF = 17408, KHT_OFF = 26112, VT_OFF = 36352, EB_OFF = 46592, BUFB = 47104, NCH = LSEQ / 32, NCHAIN = 128;
DI int crow(int r, int hi) { return (r & 3) + 8 * (r >> 2) + 4 * hi; }
DI int rowof(int b, int dir, int pos) {
    if (pos < LC) return TL + b * LC + (dir ? (LC - 1 - pos) : pos);
    const int s = pos - LC; return b * SEQ + (dir ? (SEQ - 1 - s) : s);
}
DI bf16x8 pack8(const f32x16& x, int s) { u32x4 p; p.x = pk(x[8 * s], x[8 * s + 1]); p.y = pk(x[8 * s + 2], x[8 * s + 3]); p.z = pk(x[8 * s + 4], x[8 * s + 5]); p.w = pk(x[8 * s + 6], x[8 * s + 7]); return __builtin_bit_cast(bf16x8, p); }
#define HG_MFMA(a, b, c) __builtin_amdgcn_mfma_f32_32x32x16_bf16((a), (b), (c), 0, 0, 0)

DI void scan(const Args& a, LAS unsigned char* lds, int nblk) {
    const bf16_t* P = (const bf16_t*)(a.ws + WS_P);
    const int tid = tid_(), lane = tid & 63, wid = __builtin_amdgcn_readfirstlane(tid >> 6), r32 = lane & 31, hi = lane >> 5;
    const int tau = tid & 31, pc = tid >> 5;
    for (int ch = blockIdx.x; ch < NCHAIN; ch += nblk) {
        const int b = ch >> 5, h = (ch >> 1) & 15, dir = ch & 1;
        bf16_t* O = (bf16_t*)(a.ws + (dir ? WS_OB : WS_OF));
        f32x16 S[4];
#pragma unroll
        for (int i = 0; i < 4; ++i)
#pragma unroll
            for (int r = 0; r < 16; ++r) S[i][r] = 0.f;
        u32x4 qv, lv, vv = {0u, 0u, 0u, 0u};
#define HG_LOAD(cc) do { const size_t rb = (size_t)rowof(b, dir, (cc) * 32 + tau) * HGN; \
            qv = *(const u32x4*)(P + rb + h * 128 + pc * 8); lv = *(const u32x4*)(P + rb + 2048 * (1 + dir) + h * 128 + pc * 8); \
            vv = *(const u32x4*)(P + rb + 6144 + h * 128 + pc * 8); } while (0)
        HG_LOAD(0);
        for (int c = 0; c < NCH; ++c) {
            LAS unsigned char* buf = lds + (c & 1) * BUFB;
            {
                float lf[8], qf[8], bc[8];
#pragma unroll
                for (int j = 0; j < 4; ++j) { lf[2 * j] = bf_lo(lv[j]); lf[2 * j + 1] = bf_hi(lv[j]); qf[2 * j] = bf_lo(qv[j]); qf[2 * j + 1] = bf_hi(qv[j]); }
#pragma unroll
                for (int j = 0; j < 8; ++j) { float v = lf[j];
#pragma unroll
                    for (int d = 1; d < 32; d <<= 1) { const float t = __shfl_up(v, d, 32); if (tau >= d) v += t; }
                    bc[j] = v; }
                float qh[8], qt[8], kt[8], kh[8], eb[8];
#pragma unroll
                for (int j = 0; j < 8; ++j) { const float bm = __shfl(bc[j], 15, 32), bl = __shfl(bc[j], 31, 32); const float kk = 1.0f - __expf(lf[j]);
                    qh[j] = qf[j] * __expf(bc[j]); qt[j] = qf[j] * __expf(bc[j] - bm); kt[j] = kk * __expf(bm - bc[j]); kh[j] = kk * __expf(bl - bc[j]); eb[j] = __expf(bl); }
                {   const int i = pc >> 2, hf = (pc & 3) >> 1, sec = pc & 1; const int p1 = 32 * i + 16 * hf + 4 * sec, p2 = p1 + 8;
                    u32x2 w1, w2; w1.x = pk(qh[0], qh[1]); w1.y = pk(qh[2], qh[3]); w2.x = pk(qh[4], qh[5]); w2.y = pk(qh[6], qh[7]);
                    *(LAS u32x2*)(buf + QH_OFF + tau * 272 + p1 * 2) = w1; *(LAS u32x2*)(buf + QH_OFF + tau * 272 + p2 * 2) = w2; }
                {   u32x4 w; w.x = pk(qt[0], qt[1]); w.y = pk(qt[2], qt[3]); w.z = pk(qt[4], qt[5]); w.w = pk(qt[6], qt[7]); *(LAS u32x4*)(buf + QT_OFF + tau * 272 + pc * 16) = w; }
                {   u32x4 w; w.x = pk(kt[0], kt[1]); w.y = pk(kt[2], kt[3]); w.z = pk(kt[4], kt[5]); w.w = pk(kt[6], kt[7]); *(LAS u32x4*)(buf + KT_OFF + tau * 272 + pc * 16) = w; }
#pragma unroll
                for (int j = 0; j < 8; ++j) { const unsigned w = pk(kh[j], 0.f); *(LAS bf16_t*)(buf + KHT_OFF + (8 * pc + j) * 80 + tau * 2) = (bf16_t)(w & 0xffffu); }
                {
#pragma unroll
                    for (int j = 0; j < 4; ++j) { *(LAS bf16_t*)(buf + VT_OFF + (8 * pc + 2 * j) * 80 + tau * 2) = (bf16_t)(vv[j] & 0xffffu); *(LAS bf16_t*)(buf + VT_OFF + (8 * pc + 2 * j + 1) * 80 + tau * 2) = (bf16_t)(vv[j] >> 16); }
                }
                if (tau == 31) {
#pragma unroll
                    for (int j = 0; j < 8; ++j) *(LAS float*)(buf + EB_OFF + (8 * pc + j) * 4) = eb[j];
                }
            }
            if (c + 1 < NCH) HG_LOAD(c + 1);
            __syncthreads();
            if (wid < 4) {
                const int jv = wid;
                f32x16 at;
#pragma unroll
                for (int r = 0; r < 16; ++r) at[r] = 0.f;
#pragma unroll
                for (int kk = 0; kk < 8; ++kk) { const bf16x8 ka = *(const LAS bf16x8*)(buf + KT_OFF + r32 * 272 + (16 * kk + 8 * hi) * 2), qb = *(const LAS bf16x8*)(buf + QT_OFF + r32 * 272 + (16 * kk + 8 * hi) * 2);
                    at = HG_MFMA(ka, qb, at); }
#pragma unroll
                for (int r = 0; r < 16; ++r) at[r] = (crow(r, hi) <= r32) ? at[r] : 0.f;
                const bf16x8 ab0 = pack8(at, 0), ab1 = pack8(at, 1);
                f32x16 ot;
#pragma unroll
                for (int r = 0; r < 16; ++r) ot[r] = 0.f;
                {   const LAS unsigned char* vp = buf + VT_OFF + (32 * jv + r32) * 80;
                    const s16x4 a0 = *(const LAS s16x4*)(vp + (4 * hi) * 2), a1 = *(const LAS s16x4*)(vp + (8 + 4 * hi) * 2), a2 = *(const LAS s16x4*)(vp + (16 + 4 * hi) * 2), a3 = *(const LAS s16x4*)(vp + (24 + 4 * hi) * 2);
                    const bf16x8 va0 = {a0[0], a0[1], a0[2], a0[3], a1[0], a1[1], a1[2], a1[3]}, va1 = {a2[0], a2[1], a2[2], a2[3], a3[0], a3[1], a3[2], a3[3]};
                    ot = HG_MFMA(va0, ab0, ot); ot = HG_MFMA(va1, ab1, ot); }
#pragma unroll
                for (int i = 0; i < 4; ++i) { const bf16x8 sa0 = pack8(S[i], 0), sa1 = pack8(S[i], 1);
                    const bf16x8 q0 = *(const LAS bf16x8*)(buf + QH_OFF + r32 * 272 + (32 * i + 8 * hi) * 2), q1 = *(const LAS bf16x8*)(buf + QH_OFF + r32 * 272 + (32 * i + 16 + 8 * hi) * 2);
                    ot = HG_MFMA(sa0, q0, ot); ot = HG_MFMA(sa1, q1, ot); }
                {   bf16_t* op = O + (size_t)rowof(b, dir, c * 32 + r32) * DM + h * 128 + 32 * jv + 4 * hi;
#pragma unroll
                    for (int g = 0; g < 4; ++g) { u32x2 w; w.x = pk(ot[4 * g], ot[4 * g + 1]); w.y = pk(ot[4 * g + 2], ot[4 * g + 3]); *(u32x2*)(op + 8 * g) = w; } }
#pragma unroll
                for (int i = 0; i < 4; ++i) {
#pragma unroll
                    for (int g = 0; g < 4; ++g) { const f32x4 e = *(const LAS f32x4*)(buf + EB_OFF + (32 * i + 8 * g + 4 * hi) * 4);
                        S[i][4 * g] *= e[0]; S[i][4 * g + 1] *= e[1]; S[i][4 * g + 2] *= e[2]; S[i][4 * g + 3] *= e[3]; }
#pragma unroll
                    for (int st = 0; st < 2; ++st) { const bf16x8 ka = *(const LAS bf16x8*)(buf + KHT_OFF + (32 * i + r32) * 80 + (16 * st + 8 * hi) * 2), vb = *(const LAS bf16x8*)(buf + VT_OFF + (32 * jv + r32) * 80 + (16 * st + 8 * hi) * 2);
                        S[i] = HG_MFMA(ka, vb, S[i]); }
                }
            }
        }
        __syncthreads();
#undef HG_LOAD
    }
}
}

namespace att {
constexpr int NW = 8, KVBLK = 64, NT = LSEQ / KVBLK;
constexpr float SCALE = 0.07216878364870322f;
constexpr float THR = 8.f;
constexpr int SHM_V = 16384, SHM_K = 64 * 384, V_OFF = 0, K_OFF = 2 * SHM_V, W_OFF = K_OFF + 2 * SHM_K;
#define KSWZ(row, colB) ((row) * 384 + ((colB) ^ ((((row) >> 1) & 7) << 4)))
#define SBAR() __builtin_amdgcn_sched_barrier(0)
DI int crow(int r, int hi) { return (r & 3) + 8 * (r >> 2) + 4 * hi; }
DI unsigned cvtpk(float lo, float hi) { return pk(lo, hi); }
DI int krow(int b, int k) { return k < LC ? TL + b * LC + k : b * SEQ + (k - LC); }

DI void partialSM(f32x16& p0, f32x16& p1, float& m_reg, float& mn, float& alpha) {
  constexpr float C = SCALE * 1.4426950408889634f;
  float pmax = p0[0];
#pragma unroll
  for (int r = 1; r < 16; ++r) pmax = fmaxf(pmax, p0[r]);
#pragma unroll
  for (int r = 0; r < 16; ++r) pmax = fmaxf(pmax, p1[r]);
  { auto rr = __builtin_amdgcn_permlane32_swap(__float_as_uint(pmax), __float_as_uint(pmax), false, false);
    pmax = fmaxf(__uint_as_float(rr[0]), __uint_as_float(rr[1])); }
  if (__builtin_expect(__all(pmax - m_reg <= THR / SCALE), 1)) { mn = m_reg; alpha = 1.f; }
  else { mn = fmaxf(m_reg, pmax); alpha = __builtin_amdgcn_exp2f((m_reg - mn) * C); m_reg = mn; }
  const float mnC = -mn * C;
#pragma unroll
  for (int r = 0; r < 16; ++r) p0[r] = fmaf(p0[r], C, mnC);
#pragma unroll
  for (int r = 0; r < 16; ++r) p1[r] = fmaf(p1[r], C, mnC);
#pragma unroll
  for (int r = 0; r < 16; ++r) p0[r] = __builtin_amdgcn_exp2f(p0[r]);
}
DI void finishSM(f32x16& p0, f32x16& p1, float alpha, float& l_reg, bf16x8& pa0, bf16x8& pa1, bf16x8& pa2, bf16x8& pa3) {
#pragma unroll
  for (int r = 0; r < 16; ++r) p1[r] = __builtin_amdgcn_exp2f(p1[r]);
  float ps = 0;
#pragma unroll
  for (int r = 0; r < 16; ++r) ps += p0[r];
#pragma unroll
  for (int r = 0; r < 16; ++r) ps += p1[r];
  { auto rr = __builtin_amdgcn_permlane32_swap(__float_as_uint(ps), __float_as_uint(ps), false, false);
    ps = __uint_as_float(rr[0]) + __uint_as_float(rr[1]); }
  l_reg = l_reg * alpha + ps;
#define PK4(P, BASE, OUT) do { unsigned a0 = cvtpk(P[BASE + 0], P[BASE + 1]), a1 = cvtpk(P[BASE + 2], P[BASE + 3]);   \
    unsigned b0 = cvtpk(P[BASE + 4], P[BASE + 5]), b1 = cvtpk(P[BASE + 6], P[BASE + 7]);                              \
    auto r0 = __builtin_amdgcn_permlane32_swap(a0, b0, false, false); auto r1 = __builtin_amdgcn_permlane32_swap(a1, b1, false, false); \
    u32x4 w = {r0[0], r1[0], r0[1], r1[1]}; OUT = __builtin_bit_cast(bf16x8, w); } while (0)
  PK4(p0, 0, pa0); PK4(p0, 8, pa1); PK4(p1, 0, pa2); PK4(p1, 8, pa3);
#undef PK4
}
DI void qkt(f32x16& p0, f32x16& p1, const LAS unsigned char* Ks, const bf16x8 (&qr)[12], int r32, int hi) {
#pragma unroll
  for (int r = 0; r < 16; ++r) { p0[r] = 0.f; p1[r] = 0.f; }
#pragma unroll
  for (int d0 = 0; d0 < 12; ++d0) { const int cb = (d0 * 16 + hi * 8) * 2;
    const bf16x8 b0 = *(const LAS bf16x8*)(Ks + KSWZ(r32, cb));
    const bf16x8 b1 = *(const LAS bf16x8*)(Ks + KSWZ(32 + r32, cb));
    p0 = __builtin_amdgcn_mfma_f32_32x32x16_bf16(b0, qr[d0], p0, 0, 0, 0);
    p1 = __builtin_amdgcn_mfma_f32_32x32x16_bf16(b1, qr[d0], p1, 0, 0, 0); }
}
DI int v_st(int k, int c) { const int kk = (k & ~0xC) | ((k & 4) << 1) | ((k & 8) >> 1); return ((kk >> 3) * 4 + (c >> 5)) * 512 + ((kk & 7) * 32 + (c & 31)) * 2; }
DI int v_rd_base(int lane) { return ((lane & 3) << 3) | (((lane >> 2) & 3) << 6) | (((lane >> 4) & 1) << 5) | (((lane >> 5) & 1) << 8); }
constexpr int v_rd_off(int d0, int ks, int half) { return d0 * 512 + ks * 4096 + half * 2048; }
template <int OFF> DI s16x4 tr_read(int vb) { s16x4 r; asm volatile("ds_read_b64_tr_b16 %0, %1 offset:%2" : "=&v"(r) : "v"(vb), "i"(OFF) : "memory"); return r; }
template <int D0> DI void pv_one(f32x16& od, int vb, bf16x8 pa0, bf16x8 pa1, bf16x8 pa2, bf16x8 pa3) {
  const s16x4 l0 = tr_read<v_rd_off(D0, 0, 0)>(vb), h0 = tr_read<v_rd_off(D0, 0, 1)>(vb), l1 = tr_read<v_rd_off(D0, 1, 0)>(vb), h1 = tr_read<v_rd_off(D0, 1, 1)>(vb);
  const s16x4 l2 = tr_read<v_rd_off(D0, 2, 0)>(vb), h2 = tr_read<v_rd_off(D0, 2, 1)>(vb), l3 = tr_read<v_rd_off(D0, 3, 0)>(vb), h3 = tr_read<v_rd_off(D0, 3, 1)>(vb);
  asm volatile("s_waitcnt lgkmcnt(0)" ::: "memory"); SBAR();
#define PKV(L, H) (bf16x8){L[0], L[1], L[2], L[3], H[0], H[1], H[2], H[3]}
  od = __builtin_amdgcn_mfma_f32_32x32x16_bf16(pa0, PKV(l0, h0), od, 0, 0, 0);
  od = __builtin_amdgcn_mfma_f32_32x32x16_bf16(pa1, PKV(l1, h1), od, 0, 0, 0);
  od = __builtin_amdgcn_mfma_f32_32x32x16_bf16(pa2, PKV(l2, h2), od, 0, 0, 0);
  od = __builtin_amdgcn_mfma_f32_32x32x16_bf16(pa3, PKV(l3, h3), od, 0, 0, 0);
#undef PKV
}
DI void pv_d0(f32x16 (&o)[4], int vb, bf16x8 pa0, bf16x8 pa1, bf16x8 pa2, bf16x8 pa3) {
  pv_one<0>(o[0], vb, pa0, pa1, pa2, pa3); pv_one<1>(o[1], vb, pa0, pa1, pa2, pa3); pv_one<2>(o[2], vb, pa0, pa1, pa2, pa3); pv_one<3>(o[3], vb, pa0, pa1, pa2, pa3);
}

DI void unit(const Args& a, LAS unsigned char* lds, int b, int h, int qb) {
  const bf16_t* Q = (const bf16_t*)(a.ws + WS_Q); const bf16_t* KV = (const bf16_t*)(a.ws + WS_KV); const bf16_t* KP = (const bf16_t*)(a.ws + WS_KP);
  const float* cs = (const float*)(a.ws + WS_ROPE); bf16_t* Ob = (bf16_t*)(a.ws + WS_OG);
  const int tid = tid_(), wid = tid >> 6, lane = tid & 63, r32 = lane & 31, hi = lane >> 5;
  LAS unsigned char* V_lds = lds + V_OFF; LAS unsigned char* K_lds = lds + K_OFF;
  LAS float* wsl = (LAS float*)(lds + W_OFF) + wid * 64; LAS float* li_l = wsl; LAS float* al_l = wsl + 32;
  float m_reg = -1e30f, l_reg = 0.f; f32x16 o[4]; bf16x8 qr[12];
#pragma unroll
  for (int d = 0; d < 4; ++d)
#pragma unroll
    for (int r = 0; r < 16; ++r) o[d][r] = 0.f;
  const int srow = qb * 256 + wid * 32 + r32;
  const bf16_t* Qw = Q + ((size_t)(b * SEQ + srow)) * 3072 + h * 192 + hi * 8;
#pragma unroll
  for (int d0 = 0; d0 < 8; ++d0) qr[d0] = *(const bf16x8*)(Qw + d0 * 16);
  {
      const u32x4 xa = *(const u32x4*)(Qw + 128), xb = *(const u32x4*)(Qw + 144), xc = *(const u32x4*)(Qw + 160), xd = *(const u32x4*)(Qw + 176);
      const float* cr = cs + ((srow >> 6) * 16 + hi * 8) * 2; const float* cc = cs + ((srow & 63) * 16 + hi * 8) * 2;
      float oa[8], ob[8], oc[8], od[8];
#pragma unroll
      for (int j = 0; j < 8; ++j) { const float x1 = (j & 1) ? bf_hi(xa[j >> 1]) : bf_lo(xa[j >> 1]), x2 = (j & 1) ? bf_hi(xb[j >> 1]) : bf_lo(xb[j >> 1]);
          const float c = cr[2 * j], s = cr[2 * j + 1]; oa[j] = x1 * c - x2 * s; ob[j] = x1 * s + x2 * c;
          const float y1 = (j & 1) ? bf_hi(xc[j >> 1]) : bf_lo(xc[j >> 1]), y2 = (j & 1) ? bf_hi(xd[j >> 1]) : bf_lo(xd[j >> 1]);
          const float c2 = cc[2 * j], s2 = cc[2 * j + 1]; oc[j] = y1 * c2 - y2 * s2; od[j] = y1 * s2 + y2 * c2; }
      u32x4 w;
      w.x = pk(oa[0], oa[1]); w.y = pk(oa[2], oa[3]); w.z = pk(oa[4], oa[5]); w.w = pk(oa[6], oa[7]); qr[8] = __builtin_bit_cast(bf16x8, w);
      w.x = pk(ob[0], ob[1]); w.y = pk(ob[2], ob[3]); w.z = pk(ob[4], ob[5]); w.w = pk(ob[6], ob[7]); qr[9] = __builtin_bit_cast(bf16x8, w);
      w.x = pk(oc[0], oc[1]); w.y = pk(oc[2], oc[3]); w.z = pk(oc[4], oc[5]); w.w = pk(oc[6], oc[7]); qr[10] = __builtin_bit_cast(bf16x8, w);
      w.x = pk(od[0], od[1]); w.y = pk(od[2], od[3]); w.z = pk(od[4], od[5]); w.w = pk(od[6], od[7]); qr[11] = __builtin_bit_cast(bf16x8, w);
  }
  const int sr = tid >> 4, sc = (tid & 15) * 8, vst0 = v_st(sr, sc), vst1 = v_st(32 + sr, sc);
  const int kr = tid >> 3, kc = (tid & 7) * 8;
  const int vb0 = (int)(uintptr_t)V_lds + v_rd_base(lane);
  bf16x8 vs0, vs1, ks0, ks1, kp0;
#define SLOAD(k0) do { const size_t ra = (size_t)krow(b, (k0) + sr) * 4096 + h * 256 + sc, rb2 = (size_t)krow(b, (k0) + 32 + sr) * 4096 + h * 256 + sc; \
    ks0 = *(const bf16x8*)(KV + ra); ks1 = *(const bf16x8*)(KV + rb2); vs0 = *(const bf16x8*)(KV + ra + 128); vs1 = *(const bf16x8*)(KV + rb2 + 128); \
    kp0 = *(const bf16x8*)(KP + (size_t)krow(b, (k0) + kr) * 64 + kc); } while (0)
#define SWRITE(bb) do { *(LAS bf16x8*)(V_lds + (bb) * SHM_V + vst0) = vs0; *(LAS bf16x8*)(V_lds + (bb) * SHM_V + vst1) = vs1; \
    *(LAS bf16x8*)(K_lds + (bb) * SHM_K + KSWZ(sr, sc * 2)) = ks0; *(LAS bf16x8*)(K_lds + (bb) * SHM_K + KSWZ(32 + sr, sc * 2)) = ks1; \
    *(LAS bf16x8*)(K_lds + (bb) * SHM_K + KSWZ(kr, 256 + kc * 2)) = kp0; } while (0)
  __syncthreads();
  SLOAD(0); SWRITE(0); __syncthreads();
  f32x16 p0, p1; float mn, al; bf16x8 pa0, pa1, pa2, pa3;
  for (int j = 0; j < NT; ++j) {
    const int bb = j & 1;
    if (j + 1 < NT) SLOAD((j + 1) * KVBLK);
    SBAR(); qkt(p0, p1, K_lds + bb * SHM_K, qr, r32, hi);
    partialSM(p0, p1, m_reg, mn, al);
    if (__any(al < 1.f)) { if (hi == 0) al_l[r32] = al; asm volatile("s_waitcnt lgkmcnt(0)" ::: "memory");
#pragma unroll
      for (int d = 0; d < 4; ++d)
#pragma unroll
        for (int r = 0; r < 16; ++r) o[d][r] *= al_l[crow(r, hi)]; }
    finishSM(p0, p1, al, l_reg, pa0, pa1, pa2, pa3); SBAR();
    pv_d0(o, vb0 + bb * SHM_V, pa0, pa1, pa2, pa3);
    if (j + 1 < NT) SWRITE(bb ^ 1);
    __syncthreads();
  }
  if (hi == 0) li_l[r32] = l_reg; asm volatile("s_waitcnt lgkmcnt(0)" ::: "memory");
  float rli[16];
#pragma unroll
  for (int r = 0; r < 16; ++r) rli[r] = __builtin_amdgcn_rcpf(li_l[crow(r, hi)]);
  unsigned char* Ow = (unsigned char*)Ob + ((size_t)(b * SEQ + qb * 256 + wid * 32)) * DM + h * 128;
#pragma unroll
  for (int r = 0; r < 16; ++r) { const int orow = crow(r, hi);
#pragma unroll
    for (int d0 = 0; d0 < 4; ++d0) { const unsigned w = pk8(clamp8(o[d0][r] * rli[r] * F8_OSCALE), 0.f, 0.f, 0.f); Ow[(size_t)orow * DM + d0 * 32 + r32] = (unsigned char)(w & 0xffu); } }
#undef SLOAD
#undef SWRITE
}
DI void phase(const Args& a, LAS unsigned char* lds, int G) {
  for (int u = blockIdx.x; u < NB * 16 * 16; u += G) {
    const int b = u >> 8, cc = u & 255, x = cc & 7, j = cc >> 3;
    unit(a, lds, b, 2 * x + (j >> 4), j & 15);
  }
  __syncthreads();
}
}

DI int balanced_grid(int nunits, int G) { if (nunits <= 0) return G; const int rounds = (nunits + G - 1) / G; return (nunits + rounds - 1) / rounds; }

template <bool F8, bool ACT8 = F8> DI void ph_moe_gu(const Args& a, int layer, int phase, LAS unsigned char* lds, int G) {
    unsigned char* ws = a.ws;
    moe_setup(a, layer, lds);
    const LAS int* tb256 = (const LAS int*)(lds + LCTL_OFF + 64); const LAS int* tbu = tb256; const LAS int* cn = (const LAS int*)(lds + LCTL_OFF + 256);
    const int GG = balanced_grid(tbu[32] * 16, G);
    if ((int)blockIdx.x >= GG) { cvq::service(a, lds, cvq::need(phase + 1), cvq::done_word(a, phase), 1u); return; }
    LAS unsigned* offs = (LAS unsigned*)(lds + TAB_OFF);
    constexpr int KE = F8 ? 1024 : 2048;
    typedef pg8::MoeSched<true, F8> SchedT; constexpr int RM = SchedT::RM;
    SchedT S; S.init(tbu, tb256, offs, 4096, KE, ws + WS_WGU + (size_t)layer * 32 * 4096 * 2048 * 2, GG, blockIdx.x); S.sig = cvq::done_word(a, phase);
    const int* ltok = (const int*)(ws + WS_LTOK);
    {
        const int nu = (S.nunits - S.c + GG - 1) / GG;
        for (int idx = threadIdx.x; idx < nu * RM; idx += 512) {
            const int ui = idx / RM, lr = idx - ui * RM; pg8::Unit u; S.next(ui, u);
            const int slot = u.aux + lr; const int tok = ltok[(size_t)u.e * TCAP + (slot < cn[u.e] ? slot : 0)];
            offs[idx] = (unsigned)tok * (unsigned)(KE * 2);
        }
        __syncthreads();
    }
    pg8::EpiGU<false, ACT8> E{(bf16_t*)(ws + WS_ACT), a.in[I_BGU] + (size_t)layer * 32 * 4096, F8 ? 1.0f / (F8_WSCALE * F8_ASCALE) : 1.0f};
    pg8::gemm_phase(lds, ws + WS_H2, KE, S, E);
    cvq::service(a, lds, cvq::need(phase + 1), nullptr, 0u);
}
template <bool F8> DI void ph_moe_dn(const Args& a, int layer, int phase, LAS unsigned char* lds, int G) {
    unsigned char* ws = a.ws;
    moe_setup(a, layer, lds);
    const LAS int* tb256 = (const LAS int*)(lds + LCTL_OFF + 64); const LAS int* tbu = tb256; const LAS int* cn = (const LAS int*)(lds + LCTL_OFF + 256);
    const int GG = balanced_grid(tbu[32] * 8, G);
    if ((int)blockIdx.x >= GG) { cvq::service(a, lds, cvq::need(phase + 1), cvq::done_word(a, phase), 1u); return; }
    constexpr int KE = F8 ? 1024 : 2048;
    pg8::MoeSched<false, F8> S; S.init(tbu, tb256, nullptr, 2048, KE, ws + WS_WDN + (size_t)layer * 32 * 2048 * 2048 * 2, GG, blockIdx.x); S.sig = cvq::done_word(a, phase);
    pg8::EpiDN<false> E{(bf16_t*)(ws + WS_Y2), a.in[I_BDN] + (size_t)layer * 32 * 2048, (const float*)(ws + WS_LGATE), cn, F8 ? 1.0f / (F8_WSCALE_DN * F8_ACTSCALE) : 1.0f};
    pg8::gemm_phase(lds, ws + WS_ACT, KE, S, E);
    cvq::service(a, lds, cvq::need(phase + 1), nullptr, 0u);
}

constexpr int N_PHASES = 19;
__global__ void __launch_bounds__(512, 2) mk_fwd(Args args) {
    extern __shared__ __attribute__((aligned(16))) unsigned char lds_raw[];
    LAS unsigned char* lds = (LAS unsigned char*)lds_raw;
    const int G = gridDim.x;
    unsigned char* ws = args.ws;
    for (int u = threadIdx.x; u < 256; u += 512) ((LAS unsigned*)(lds + LCTL_OFF))[u] = 0u;
    __syncthreads();
#if MK_PER_PHASE
#define GRID_BAR() do { } while (0)
#else
    XcdBarrier bar = xcd_barrier_post((unsigned*)(ws + WS_CTL), (volatile LAS unsigned*)(lds + LCTL_OFF));
#define GRID_BAR() xcd_barrier(bar)
#endif
    const int lo = args.ph_lo, hi = args.ph_hi;
#ifndef MK_MASK
#define MK_MASK 0xFFFFFFu
#endif
#define IN(k) (((MK_MASK >> (k)) & 1u) && lo <= (k) && (k) < hi)
#define SEAM(k) do { if (IN((k) + 1)) GRID_BAR(); } while (0)
    const float* modv = (const float*)(ws + WS_MODV);

#ifndef MK_REP
#define MK_REP 0u
#endif
#define PHASE(k, ...) do { if (IN(k)) { __VA_ARGS__; if ((MK_REP >> (k)) & 1u) { GRID_BAR(); __VA_ARGS__; } cvq::service(args, lds, cvq::need((k) + 1), nullptr, 0u); SEAM(k); } } while (0)
#define GEMM_PHASE(k, GG, M_, N_, ...) GEMM_PHASE_U(k, GG, ((M_) / 256) * ((N_) / 256), __VA_ARGS__)
#define GEMM_PHASE_U(k, GG, NU_, ...) do { if (IN(k)) { const int GG = balanced_grid((NU_), G); \
        if ((int)blockIdx.x < GG) { __VA_ARGS__; cvq::service(args, lds, cvq::need((k) + 1), nullptr, 0u); } \
        else cvq::service(args, lds, cvq::need((k) + 1), cvq::done_word(args, (k)), 1u); \
        SEAM(k); } } while (0)
    PHASE(0, p0_prologue(args, lds, G));
    PHASE(1, ph_modulate(args.in[I_X], args.in[I_CTX], modv, 0, 1, (bf16_t*)(ws + WS_H), G));
    GEMM_PHASE(2, GG, T, HGN, { pg8::PlainSched<true> S; S.init(T, HGN, 1024, ws + WS_WHGIN, GG, blockIdx.x); S.sig = cvq::done_word(args, 2);
               pg8::EpiHgIn E{(bf16_t*)(ws + WS_P), (const float*)(ws + WS_LB), 1.0f / (F8_WSCALE * F8_ASCALE)}; pg8::gemm_phase(lds, ws + WS_H, 1024, S, E); });
    if (IN(3)) {
        if ((int)blockIdx.x < hg::NCHAIN) { hg::scan(args, lds, hg::NCHAIN); cvq::signal_done(args, 3); cvq::service(args, lds, cvq::need(4), nullptr, 0u); }
        else cvq::service(args, lds, cvq::need(4), cvq::done_word(args, 3), (unsigned)hg::NCHAIN);
        SEAM(3);
    }
    PHASE(4, ph_hg_combine(args, G));
    GEMM_PHASE_U(5, GG, (T / 256) * 8, { pg8::PlainSched<true> S; S.init(T, 2048, 1024, ws + WS_WHGO, GG, blockIdx.x); S.sig = cvq::done_word(args, 5);
               pg8::EpiBf16<false> E{(bf16_t*)(ws + WS_Y), 2048, 2048, 1.0f / (F8_WSCALE_DN * F8_OGSCALE)}; pg8::gemm_phase(lds, ws + WS_OG, 1024, S, E); });
    PHASE(6, ph_post_router(args, 0, args.in[I_X], args.in[I_CTX], (const bf16_t*)(ws + WS_Y), T, lds, G));
    if (IN(7)) { ph_moe_gu<true>(args, 0, 7, lds, G); SEAM(7); }
    if (IN(8)) { ph_moe_dn<true>(args, 0, 8, lds, G); SEAM(8); }
    PHASE(9, ph_post_ffn(args, 0, T, (float*)(ws + WS_X2), true, lds, G));
    GEMM_PHASE(10, GG, T, 1280, { pg8::PlainSched<> S; S.init(T, 1280, 2048, ws + WS_WMIN, GG, blockIdx.x); S.sig = cvq::done_word(args, 10); pg8::EpiF32 E{(float*)(ws + WS_PM), 1088, 1088};
                pg8::gemm_phase(lds, ws + WS_H, 2048, S, E); });
    PHASE(11, ph_mla_local(args, G));
    PHASE(12, { { pg8::PlainSched<> S; S.init(TL, 3072, 512, ws + WS_WUQ, G, blockIdx.x); pg8::EpiBf16<> E{(bf16_t*)(ws + WS_Q), 3072, 3072, 1.0f}; pg8::gemm_phase(lds, ws + WS_CQN, 512, S, E); }
                { pg8::PlainSched<> S; S.init(T, 4096, 512, ws + WS_WUKV, G, blockIdx.x); pg8::EpiBf16<> E{(bf16_t*)(ws + WS_KV), 4096, 4096, 1.0f}; pg8::gemm_phase(lds, ws + WS_CKVN, 512, S, E); } });
    PHASE(13, att::phase(args, lds, G));
    PHASE(14, { pg8::PlainSched<true> S; S.init(TL, 2048, 1024, ws + WS_WMO, G, blockIdx.x); pg8::EpiBf16<false> E{(bf16_t*)(ws + WS_Y), 2048, 2048, 1.0f / (F8_WSCALE_DN * F8_OSCALE)};
                pg8::gemm_phase(lds, ws + WS_OG, 1024, S, E); });
    PHASE(15, ph_post_router(args, 1, (const float*)(ws + WS_X2), (const float*)(ws + WS_X2) + (size_t)TL * DM, (const bf16_t*)(ws + WS_Y), TL, lds, G));
    if (IN(16)) { ph_moe_gu<true>(args, 1, 16, lds, G); SEAM(16); }
    if (IN(17)) { ph_moe_dn<true>(args, 1, 17, lds, G); SEAM(17); }
    if (IN(18)) { ph_post_ffn(args, 1, TL, args.out, false, lds, G); if ((MK_REP >> 18) & 1u) { GRID_BAR(); ph_post_ffn(args, 1, TL, args.out, false, lds, G); } }
#undef GEMM_PHASE
#undef GEMM_PHASE_U
#undef PHASE
#undef IN
#undef SEAM
}

extern "C" void kernel_launch(void* const* d_in, const int* in_sizes, int n_in, void* d_out, int out_size, void* d_ws, size_t ws_size, hipStream_t stream) {
    static int grid = 0;
    if (grid == 0) {
        if (n_in != 24 || out_size != TL * DM || ws_size < WS_END) { fprintf(stderr, "kernel_launch: shape mismatch: n_in %d out %d ws %zu (need %zu)\n", n_in, out_size, ws_size, (size_t)WS_END); grid = -1; return; }
        int dev = 0, cus = 0, per_cu = 0;
        if (hipGetDevice(&dev) != hipSuccess || hipDeviceGetAttribute(&cus, hipDeviceAttributeMultiprocessorCount, dev) != hipSuccess) { grid = -1; return; }
        if (hipFuncSetAttribute((const void*)mk_fwd, hipFuncAttributeMaxDynamicSharedMemorySize, LDS_BYTES) != hipSuccess) { fprintf(stderr, "kernel_launch: hipFuncSetAttribute failed\n"); grid = -1; return; }
        if (hipOccupancyMaxActiveBlocksPerMultiprocessor(&per_cu, (const void*)mk_fwd, 512, LDS_BYTES) != hipSuccess || per_cu < 1) fprintf(stderr, "kernel_launch: occupancy query reports %d\n", per_cu);
        (void)hipGetLastError();
        grid = cus;
        if (grid != 256) { fprintf(stderr, "kernel_launch: built for 256 CUs, device has %d\n", cus); grid = -1; return; }
    }
    if (grid < 0) return;
    (void)hipMemsetAsync((char*)d_ws + WS_CTL, 0, CTL_BYTES, stream);
    Args a{};
    for (int i = 0; i < 24; ++i) a.in[i] = (const float*)d_in[i];
    a.out = (float*)d_out; a.ws = (unsigned char*)d_ws;
#if MK_PER_PHASE
    for (int p = 0; p < N_PHASES; ++p) { a.ph_lo = p; a.ph_hi = p + 1; hipLaunchKernelGGL(mk_fwd, dim3(grid), dim3(512), LDS_BYTES, stream, a); }
#else
    a.ph_lo = 0; a.ph_hi = N_PHASES;
    hipLaunchKernelGGL(mk_fwd, dim3(grid), dim3(512), LDS_BYTES, stream, a);
#endif
    const hipError_t le = hipPeekAtLastError();
    if (le != hipSuccess) fprintf(stderr, "kernel_launch: launch failed: %s\n", hipGetErrorName(le));
}
```
